# Optimizing an MI355X kernel written in HIP

```python
import jax, jax.numpy as jnp
from jax import lax
import numpy as np

D_MODEL = 1024
BATCH = 4
SEQ = 8192
DEPTH = 1

CHUNK = 64
N_LEFT_CHUNKS = 8
BAND = (N_LEFT_CHUNKS + 1) * CHUNK
MIX_WIDTH = D_MODEL
ATTN_WIDTH = MIX_WIDTH // 2
HEAD_DIM = 64
N_HEADS = ATTN_WIDTH // HEAD_DIM
REL_CLIP = 256
POOL_WIDTH = MIX_WIDTH - ATTN_WIDTH
POOL_WINDOWS = (2, 4, 8, 16)
N_POOL_GROUPS = len(POOL_WINDOWS)
POOL_GROUP = POOL_WIDTH // N_POOL_GROUPS
IN_WIDTH = 3 * ATTN_WIDTH + POOL_WIDTH + MIX_WIDTH
EPS = 1e-6
NEG_INF = -1e30

kernel_name = "hybrid_chunk_attn_pool_block"


def rms_norm(x, g):
    xf = x.astype(jnp.float32)
    y = xf * lax.rsqrt(jnp.mean(xf * xf, axis=-1, keepdims=True) + EPS)
    return (y * g.astype(jnp.float32)).astype(x.dtype)


def chunk_attention(q, k, v, rel_bias):
    B, S, H, Dh = q.shape
    n_chunks = S // CHUNK
    pad = N_LEFT_CHUNKS * CHUNK
    kp = jnp.pad(k, ((0, 0), (pad, 0), (0, 0), (0, 0)))
    vp = jnp.pad(v, ((0, 0), (pad, 0), (0, 0), (0, 0)))
    a = jnp.arange(CHUNK)[:, None]
    j = jnp.arange(BAND)[None, :]
    rel = j - pad - a
    idx = jnp.clip(rel, -REL_CLIP, REL_CLIP) + REL_CLIP
    bias = rel_bias.astype(jnp.float32)[:, idx]
    scale = HEAD_DIM ** -0.5
    band_offsets = jnp.arange(BAND) - pad

    def one_chunk(n):
        start = n * CHUNK
        qn = lax.dynamic_slice_in_dim(q, start, CHUNK, axis=1)
        kn = lax.dynamic_slice_in_dim(kp, start, BAND, axis=1)
        vn = lax.dynamic_slice_in_dim(vp, start, BAND, axis=1)
        s = jnp.einsum('bqhd,bkhd->bhqk', qn, kn).astype(jnp.float32) * scale + bias[None]
        valid = (start + band_offsets) >= 0
        s = jnp.where(valid[None, None, None, :], s, NEG_INF)
        p = jax.nn.softmax(s, axis=-1).astype(vn.dtype)
        return jnp.einsum('bhqk,bkhd->bqhd', p, vn)

    out = lax.map(one_chunk, jnp.arange(n_chunks))
    return jnp.transpose(out, (1, 0, 2, 3, 4)).reshape(B, S, H * Dh)


def multiscale_pool(u, w_pool, pool_scale):
    B, S, _ = u.shape
    uf = u.astype(jnp.float32).reshape(B, S, N_POOL_GROUPS, POOL_GROUP)
    cs = jnp.concatenate([jnp.zeros((B, 1, N_POOL_GROUPS, POOL_GROUP), jnp.float32),
                          jnp.cumsum(uf, axis=1)], axis=1)
    t = jnp.arange(S)[:, None]
    win = jnp.array(POOL_WINDOWS, dtype=jnp.int32)[None, :]
    lo = jnp.maximum(t + 1 - win, 0)
    cnt = jnp.minimum(t + 1, win).astype(jnp.float32)
    g_idx = jnp.arange(N_POOL_GROUPS)[None, :]
    window_sum = cs[:, 1:] - cs[:, lo, g_idx]
    mixed = window_sum / cnt[None, :, :, None] - uf
    y = jnp.einsum('bsgi,gio->bsgo', mixed.astype(u.dtype), w_pool)
    return y.reshape(B, S, POOL_WIDTH) * pool_scale


def setup_inputs(seed: int = 0) -> dict:
    key = jax.random.key(seed)
    ks = jax.random.split(key, 12)
    f32 = jnp.float32
    x = jax.random.normal(ks[0], (BATCH, SEQ, D_MODEL), f32)
    c = jax.random.normal(ks[1], (BATCH, D_MODEL), f32)
    norm_g = 1.0 + 0.02 * jax.random.normal(ks[2], (DEPTH, D_MODEL), f32)
    w_ada = 0.5 * D_MODEL ** -0.5 * jax.random.normal(ks[3], (DEPTH, D_MODEL, 3 * D_MODEL), f32)
    b_ada = 0.02 * jax.random.normal(ks[4], (DEPTH, 3 * D_MODEL), f32)
    w_in = D_MODEL ** -0.5 * jax.random.normal(ks[5], (DEPTH, D_MODEL, IN_WIDTH), f32)
    q_norm_g = 1.0 + 0.02 * jax.random.normal(ks[6], (DEPTH, HEAD_DIM), f32)
    k_norm_g = 1.0 + 0.02 * jax.random.normal(ks[7], (DEPTH, HEAD_DIM), f32)
    rel_bias = 0.5 * jax.random.normal(ks[8], (DEPTH, N_HEADS, 2 * REL_CLIP + 1), f32)
    w_pool = POOL_GROUP ** -0.5 * jax.random.normal(ks[9], (DEPTH, N_POOL_GROUPS, POOL_GROUP, POOL_GROUP), f32)
    pool_scale = 1.0 + 0.02 * jax.random.normal(ks[10], (DEPTH, POOL_WIDTH), f32)
    w_out = MIX_WIDTH ** -0.5 * jax.random.normal(ks[11], (DEPTH, MIX_WIDTH, D_MODEL), f32)
    return {"x": x, "c": c, "norm_g": norm_g, "w_ada": w_ada, "b_ada": b_ada,
            "w_in": w_in, "q_norm_g": q_norm_g, "k_norm_g": k_norm_g,
            "rel_bias": rel_bias, "w_pool": w_pool, "pool_scale": pool_scale,
            "w_out": w_out}


def reference(x, c, norm_g, w_ada, b_ada, w_in, q_norm_g, k_norm_g, rel_bias,
              w_pool, pool_scale, w_out):
    B, S, _ = x.shape
    for l in range(DEPTH):
        mod = c @ w_ada[l] + b_ada[l]
        shift, scale, gate = jnp.split(mod, 3, axis=-1)
        h = rms_norm(x, norm_g[l]) * (1.0 + scale[:, None, :]) + shift[:, None, :]
        proj = h @ w_in[l]
        o1 = ATTN_WIDTH
        o2 = 2 * ATTN_WIDTH
        o3 = 3 * ATTN_WIDTH
        o4 = o3 + POOL_WIDTH
        q = rms_norm(proj[..., :o1].reshape(B, S, N_HEADS, HEAD_DIM), q_norm_g[l])
        k = rms_norm(proj[..., o1:o2].reshape(B, S, N_HEADS, HEAD_DIM), k_norm_g[l])
        v = proj[..., o2:o3].reshape(B, S, N_HEADS, HEAD_DIM)
        u = proj[..., o3:o4]
        z = proj[..., o4:]
        a_out = chunk_attention(q, k, v, rel_bias[l])
        p_out = multiscale_pool(u, w_pool[l], pool_scale[l])
        y = jnp.concatenate([a_out, p_out], axis=-1) * jax.nn.silu(z)
        x = x + gate[:, None, :] * (y @ w_out[l])
    return x
```

```cpp
#include <hip/hip_runtime.h>
#include <cstdint>
#include <cstdio>

constexpr int BATCH = 4, SEQ = 8192, DM = 1024, M = BATCH * SEQ;
constexpr int NH = 8, HD = 64, AW = 512, PW = 512, INW = 3072;
constexpr int CHUNK = 64, NLEFT = 8, RELCLIP = 256;
constexpr float EPS = 1e-6f;

__global__ void k_mod(const float* __restrict__ c, const float* __restrict__ w_ada, const float* __restrict__ b_ada, float* __restrict__ mod) {
    const int n = blockIdx.x * 256 + threadIdx.x;
    float acc[4];
    for (int b = 0; b < 4; ++b) acc[b] = b_ada[n];
    for (int k = 0; k < DM; ++k) { const float w = w_ada[(size_t)k * 3072 + n];
        for (int b = 0; b < 4; ++b) acc[b] += c[b * DM + k] * w; }
    for (int b = 0; b < 4; ++b) mod[b * 3072 + n] = acc[b];
}

__global__ void k_adaln(const float* __restrict__ x, const float* __restrict__ g, const float* __restrict__ mod, float* __restrict__ h) {
    __shared__ float red[4];
    const int row = blockIdx.x, b = row / SEQ, t = threadIdx.x;
    const float4 v = ((const float4*)(x + (size_t)row * DM))[t];
    float s = v.x * v.x + v.y * v.y + v.z * v.z + v.w * v.w;
    for (int o = 32; o > 0; o >>= 1) s += __shfl_xor(s, o);
    if ((t & 63) == 0) red[t >> 6] = s;
    __syncthreads();
    const float tot = red[0] + red[1] + red[2] + red[3];
    const float rstd = 1.0f / sqrtf(tot / DM + EPS);
    const float* shift = mod + b * 3072; const float* scale = shift + 1024;
    float o[4] = {v.x, v.y, v.z, v.w};
    for (int j = 0; j < 4; ++j) { const int cidx = 4 * t + j; o[j] = o[j] * rstd * g[cidx] * (1.0f + scale[cidx]) + shift[cidx]; }
    ((float4*)(h + (size_t)row * DM))[t] = make_float4(o[0], o[1], o[2], o[3]);
}

__global__ void __launch_bounds__(256) k_gemm(const float* __restrict__ A, int lda, const float* __restrict__ B, int ldb, float* __restrict__ C, int ldc, int K) {
    __shared__ float As[16][64 + 4];
    __shared__ float Bs[16][64 + 4];
    const int tid = threadIdx.x, tx = tid & 15, ty = tid >> 4;
    const int m0 = blockIdx.y * 64, n0 = blockIdx.x * 64;
    float acc[4][4] = {};
    for (int k0 = 0; k0 < K; k0 += 16) {
        { const int r = tid >> 2, kk = (tid & 3) * 4; const float4 a = *(const float4*)(A + (size_t)(m0 + r) * lda + k0 + kk);
          As[kk + 0][r] = a.x; As[kk + 1][r] = a.y; As[kk + 2][r] = a.z; As[kk + 3][r] = a.w; }
        { const int kk = tid >> 4, c4 = (tid & 15) * 4; const float4 b = *(const float4*)(B + (size_t)(k0 + kk) * ldb + n0 + c4);
          *(float4*)&Bs[kk][c4] = b; }
        __syncthreads();
#pragma unroll
        for (int kk = 0; kk < 16; ++kk) {
            const float4 a = *(const float4*)&As[kk][ty * 4]; const float4 b = *(const float4*)&Bs[kk][tx * 4];
            const float av[4] = {a.x, a.y, a.z, a.w}, bv[4] = {b.x, b.y, b.z, b.w};
#pragma unroll
            for (int i = 0; i < 4; ++i)
#pragma unroll
                for (int j = 0; j < 4; ++j) acc[i][j] += av[i] * bv[j];
        }
        __syncthreads();
    }
    for (int i = 0; i < 4; ++i) *(float4*)(C + (size_t)(m0 + ty * 4 + i) * ldc + n0 + tx * 4) = make_float4(acc[i][0], acc[i][1], acc[i][2], acc[i][3]);
}

__global__ void k_qknorm(float* __restrict__ proj, const float* __restrict__ qg, const float* __restrict__ kg) {
    const int idx = blockIdx.x * 256 + threadIdx.x; const int row = idx >> 4, hh = idx & 15;
    float* p = proj + (size_t)row * INW + hh * 64; const float* g = hh < 8 ? qg : kg;
    float s = 0.f; for (int d = 0; d < 64; ++d) s += p[d] * p[d];
    const float r = 1.0f / sqrtf(s / 64.f + EPS);
    for (int d = 0; d < 64; ++d) p[d] = p[d] * r * g[d];
}

__global__ void __launch_bounds__(64) k_attn(float* __restrict__ proj, const float* __restrict__ rel_bias) {
    const int idx = blockIdx.x * 64 + threadIdx.x;
    const int i = idx % SEQ, bh = idx / SEQ, h = bh % NH, b = bh / NH;
    float* qp = proj + ((size_t)b * SEQ + i) * INW + h * 64;
    float q[64], o[64];
#pragma unroll
    for (int d = 0; d < 64; ++d) { q[d] = qp[d]; o[d] = 0.f; }
    const int n = i / CHUNK; int j0 = (n - NLEFT) * CHUNK; if (j0 < 0) j0 = 0; const int j1 = n * CHUNK + CHUNK - 1;
    float mx = -1e30f, l = 0.f;
    for (int j = j0; j <= j1; ++j) {
        const float* kp = proj + ((size_t)b * SEQ + j) * INW + 512 + h * 64; const float* vp = kp + 512;
        float s = 0.f;
#pragma unroll
        for (int d = 0; d < 64; ++d) s += q[d] * kp[d];
        int rel = j - i; rel = rel < -RELCLIP ? -RELCLIP : (rel > RELCLIP ? RELCLIP : rel);
        s = s * 0.125f + rel_bias[h * (2 * RELCLIP + 1) + rel + RELCLIP];
        const float mn = fmaxf(mx, s), f = __expf(mx - mn), p = __expf(s - mn);
        l = l * f + p; mx = mn;
#pragma unroll
        for (int d = 0; d < 64; ++d) o[d] = o[d] * f + p * vp[d];
    }
    const float rl = 1.0f / l;
#pragma unroll
    for (int d = 0; d < 64; ++d) qp[d] = o[d] * rl;
}

__global__ void k_mixed(float* __restrict__ proj) {
    const int idx = blockIdx.x * 256 + threadIdx.x; const int row = idx >> 9, ch = idx & 511, g = ch >> 7, w = 2 << g;
    const int t = row % SEQ; const int cnt = (t + 1 < w) ? t + 1 : w;
    float s = 0.f; for (int a = 0; a < cnt; ++a) s += proj[(size_t)(row - a) * INW + 1536 + ch];
    proj[(size_t)row * INW + 1024 + ch] = s / (float)cnt - proj[(size_t)row * INW + 1536 + ch];
}

__global__ void k_y(float* __restrict__ proj, const float* __restrict__ ps) {
    const size_t idx = (size_t)blockIdx.x * 256 + threadIdx.x; const size_t row = idx >> 10; const int cidx = (int)(idx & 1023);
    float v = proj[row * INW + cidx]; if (cidx >= 512) v *= ps[cidx - 512];
    const float z = proj[row * INW + 2048 + cidx];
    proj[row * INW + cidx] = v * (z / (1.0f + __expf(-z)));
}

__global__ void k_out(float* __restrict__ out, const float* __restrict__ x, const float* __restrict__ mod) {
    const size_t idx = (size_t)blockIdx.x * 256 + threadIdx.x; const size_t row = idx >> 10; const int cidx = (int)(idx & 1023); const int b = (int)(row / SEQ);
    out[idx] = x[idx] + mod[b * 3072 + 2048 + cidx] * out[idx];
}

extern "C" void kernel_launch(void* const* d_in, const int* in_sizes, int n_in, void* d_out, int out_size, void* d_ws, size_t ws_size, hipStream_t stream) {
    const float* x = (const float*)d_in[0]; const float* c = (const float*)d_in[1]; const float* norm_g = (const float*)d_in[2];
    const float* w_ada = (const float*)d_in[3]; const float* b_ada = (const float*)d_in[4]; const float* w_in = (const float*)d_in[5];
    const float* qg = (const float*)d_in[6]; const float* kg = (const float*)d_in[7]; const float* rel_bias = (const float*)d_in[8];
    const float* w_pool = (const float*)d_in[9]; const float* ps = (const float*)d_in[10]; const float* w_out = (const float*)d_in[11];
    float* out = (float*)d_out;
    float* proj = (float*)d_ws;
    float* mod = (float*)((char*)d_ws + (size_t)384 * 1024 * 1024);
    float* h = out;
    k_mod<<<3072 / 256, 256, 0, stream>>>(c, w_ada, b_ada, mod);
    k_adaln<<<M, 256, 0, stream>>>(x, norm_g, mod, h);
    k_gemm<<<dim3(INW / 64, M / 64), 256, 0, stream>>>(h, DM, w_in, INW, proj, INW, DM);
    k_qknorm<<<M * 16 / 256, 256, 0, stream>>>(proj, qg, kg);
    k_attn<<<BATCH * NH * SEQ / 64, 64, 0, stream>>>(proj, rel_bias);
    k_mixed<<<M * 512 / 256, 256, 0, stream>>>(proj);
    for (int g = 0; g < 4; ++g)
        k_gemm<<<dim3(128 / 64, M / 64), 256, 0, stream>>>(proj + 1024 + g * 128, INW, w_pool + (size_t)g * 128 * 128, 128, proj + 512 + g * 128, INW, 128);
    k_y<<<M * 1024 / 256, 256, 0, stream>>>(proj, ps);
    k_gemm<<<dim3(DM / 64, M / 64), 256, 0, stream>>>(proj, INW, w_out, DM, out, DM, DM);
    k_out<<<M * 1024 / 256, 256, 0, stream>>>(out, x, mod);
}
```

```cpp
#include <hip/hip_runtime.h>
#include <hip/hip_bf16.h>
#include <cstdio>
#include <cstdint>
#include <cmath>

constexpr int BATCH = 4, SEQ = 8192, DMODEL = 1024, MROWS = BATCH * SEQ;
constexpr int NHEAD = 8, HDIM = 64, AW = 512, PWID = 512, NPROJ = 3072;
constexpr float RMS_EPS = 1e-6f;
constexpr float LOG2E = 1.4426950408889634f;
constexpr float QSCALE = 0.125f * LOG2E;
#define DBG_NAIVE 0
#define MK_N_LAUNCHES 1
#define PROBE_P2B 0
#define P4_ALIGN true
#define POOL_FIRST 1
#define ATT_PRIO 0
#define GEMM_ORDER pg8::StaticOrder
#define WS_AT_END 0
#define WGM_P4 4
#define WT_STORES 0
#define QUARTERS 0
#define STAG_TICKS 1400
#define SHADOW_NODMA 0
#define USE_COOP 1
#define SHADOW_EPI4 0
#define SHADOW_EPI2 0
#define SHADOW_VAR -1
#define X_PREFETCH 0
#define X_PREFETCH_AT 3
#define P4_STAGGER_TICKS 0
#define PROBE_STAMP -1
#define PROBE_AMP 4
#define REP_P0 1
#define REP_P1 1
#define REP_P2 1
#define REP_P3A 1
#define REP_P3B 1
#define REP_P4 1
#define REP_BAR 1
#define REP_ALL 1
#define REP_MEMSET 1
#define REP_EPI4 1
namespace pg8 {
#define PG8_LAS __attribute__((address_space(3)))
typedef unsigned short bf16_t;
typedef short bf16x8 __attribute__((ext_vector_type(8)));
typedef float f32x4 __attribute__((ext_vector_type(4)));
typedef unsigned u32x4 __attribute__((ext_vector_type(4)));
constexpr int BM = 256, BK = 64, HALF = 128, HTB = HALF * BK * 2  , STAGE_BYTES = 8 * HTB, NXCD = 8, WGM = 4;

__host__ __device__ __forceinline__ int lds_byte(int r, int c) { const int st = (r >> 4) * 2 + (c >> 5), rr = r & 15, cc = c & 31, ob = rr * 64 + cc * 2; return st * 1024 + (ob ^ (((ob >> 9) & 1) << 5)); }
__host__ __device__ __forceinline__ void stage_rc(int b, int& R, int& C) { const int st = b / 1024, sb = b % 1024, swz = sb ^ (((sb >> 9) & 1) << 5); R = (st >> 1) * 16 + swz / 64; C = (st & 1) * 32 + (swz % 64) / 2; }
__host__ __device__ __forceinline__ int perm32(int rho) { const int n = rho >> 4, i = rho & 15; return 8 * (i >> 2) + 4 * n + (i & 3); }

struct Unit { int pm, pn, sh; };
struct Gemm { const bf16_t* A; const bf16_t* Bt; int M, N, K; };

struct StaticOrder {
    int nM, nN, nwg, G, c, rep, wgm;
    __host__ __device__ void init(int M, int N, int G_, int c_, int rep_ = 1, int wgm_ = WGM) { nM = M / BM; nN = N / BM; nwg = nM * nN; G = G_; c = c_; rep = rep_; wgm = wgm_; }
    __host__ __device__ bool next(int i, Unit& u) const {
        const int per = (nwg - c + G - 1) / G;
        if (per <= 0 || i >= per * rep) return false;
        const long L = (long)(i % per) * G + c; if (L >= nwg) return false; u.sh = (i >= per);
        int wgid = (int)L; { const int q = nwg / NXCD, r = nwg % NXCD, xcd = wgid % NXCD, off = wgid / NXCD; wgid = (xcd < r ? xcd * (q + 1) : r * (q + 1) + (xcd - r) * q) + off; }
        const int nig = wgm * nN, gid = wgid / nig, fm = gid * wgm, gsz = (nM - fm) < wgm ? (nM - fm) : wgm;
        u.pm = fm + ((wgid % nig) % gsz); u.pn = (wgid % nig) / gsz; return true;
    }
    __device__ __forceinline__ void a_ready(const Unit&) const {}
    __device__ __forceinline__ void done(const Unit&) const {}
};

struct HalvesOrder {
    int nM, nN, half, xh, cx;
    __host__ __device__ void init(int M, int N, int G, int c) { nM = M / BM; nN = N / BM; half = G / 2; xh = c / half; cx = c % half; }
    __host__ __device__ bool next(int i, Unit& u) const {
        const int mh = nM / 2, t = i * half + cx; if (t >= mh * nN) return false;
        const int nig = WGM * nN, g = t / nig, r = t % nig;
        u.pm = xh * mh + g * WGM + (r % WGM); u.pn = r / WGM; u.sh = 0; return true;
    }
    __device__ __forceinline__ void a_ready(const Unit&) const {}
    __device__ __forceinline__ void done(const Unit&) const {}
};

struct BlockOrder {
    int nM, nN, x, cx, rep;
    __host__ __device__ void init(int M, int N, int G, int c, int rep_ = 1) { nM = M / BM; nN = N / BM; x = c % 8; cx = c / 8; rep = rep_; (void)G; }
    __host__ __device__ bool next(int i, Unit& u) const {
        const int nb = nN / 4, mper = nM / 8, per = (mper / 8) * nb; if (i >= per * rep) return false;
        const int ii = i % per, mg = ii / nb, cb = ii % nb;
        u.pm = x * mper + 8 * mg + (cx & 7); u.pn = 4 * cb + (cx >> 3); u.sh = (i >= per); return true;
    }
    __device__ __forceinline__ void a_ready(const Unit&) const {}
    __device__ __forceinline__ void done(const Unit&) const {}
};
__device__ __forceinline__ unsigned cvt_pk_bf16(float lo, float hi) { unsigned r; asm volatile("v_cvt_pk_bf16_f32 %0, %1, %2" : "=v"(r) : "v"(lo), "v"(hi)); return r; }
__device__ __forceinline__ float silu_f(float v) { return v * __builtin_amdgcn_rcpf(1.0f + __builtin_amdgcn_exp2f(-1.4426950408889634f * v)); }
struct EpiProj {
    static constexpr bool PERM = true, AFTER_DRAIN = false, HEADPERM = true;
    bf16_t *Q, *Kb, *V, *U, *SZ; const float *qg, *kg; float qscale; PG8_LAS unsigned char* xl;
    template <int MODE> __device__ __forceinline__ void run(const f32x4 (&acc)[2][2][4][2], bf16_t* base, int ldc, int colw, int rowt, const float* g, float sc, int fr, int fq, PG8_LAS unsigned char* patch) const {
        const int lane = fq * 16 + fr, rr = lane >> 3, cc = lane & 7;
        PG8_LAS unsigned char* wp = patch + fr * 144 + fq * 16;
        const PG8_LAS unsigned char* rp = patch + rr * 144 + cc * 16;
        f32x4 gv[2][2];
        if (MODE == 0) {
#pragma unroll
            for (int bj = 0; bj < 2; ++bj)
#pragma unroll
                for (int n = 0; n < 2; ++n) gv[bj][n] = *(const f32x4*)(g + 32 * bj + 8 * fq + 4 * n) * sc;
        }
#pragma unroll
        for (int ai = 0; ai < 2; ++ai)
#pragma unroll
            for (int m = 0; m < 4; ++m) {
                float rs = 1.f;
                if (MODE == 0) {
                    float ss = 0.f;
#pragma unroll
                    for (int bj = 0; bj < 2; ++bj)
#pragma unroll
                        for (int n = 0; n < 2; ++n) { const f32x4 x = acc[ai][bj][m][n]; ss += (x[0] * x[0] + x[1] * x[1]) + (x[2] * x[2] + x[3] * x[3]); }
                    ss += __shfl_xor(ss, 16); ss += __shfl_xor(ss, 32);
                    rs = 1.0f / sqrtf(ss * (1.0f / 64.0f) + 1e-6f);
                }
#pragma unroll
                for (int bj = 0; bj < 2; ++bj) {
                    f32x4 v0 = acc[ai][bj][m][0], v1 = acc[ai][bj][m][1];
                    if (MODE == 0) { v0 = v0 * rs * gv[bj][0]; v1 = v1 * rs * gv[bj][1]; }
                    if (MODE == 2) {
#pragma unroll
                        for (int j = 0; j < 4; ++j) { v0[j] = silu_f(v0[j]); v1[j] = silu_f(v1[j]); } }
                    u32x4 w; w.x = cvt_pk_bf16(v0[0], v0[1]); w.y = cvt_pk_bf16(v0[2], v0[3]); w.z = cvt_pk_bf16(v1[0], v1[1]); w.w = cvt_pk_bf16(v1[2], v1[3]);
                    *(PG8_LAS u32x4*)(wp + bj * 64) = w;
                }
                const u32x4 t0 = *(const PG8_LAS u32x4*)(rp), t1 = *(const PG8_LAS u32x4*)(rp + 8 * 144);
                bf16_t* rowp = base + (size_t)(rowt + ai * HALF + m * 16 + rr) * ldc + colw + cc * 8;
#if WT_STORES
                asm volatile("global_store_dwordx4 %0, %1, off sc1\n\ts_nop 1" :: "v"(rowp), "v"(t0) : "memory");
                asm volatile("global_store_dwordx4 %0, %1, off sc1\n\ts_nop 1" :: "v"(rowp + (size_t)8 * ldc), "v"(t1) : "memory");
#else
                *(u32x4*)(rowp) = t0; *(u32x4*)(rowp + (size_t)8 * ldc) = t1;
#endif
            }
    }
    __device__ __forceinline__ void operator()(const f32x4 (&acc)[2][2][4][2], const Unit& u, int wr, int wc, int fr, int fq) const {
        const int pn = u.pn, rowt = u.pm * BM + wr * 64, cw = wc * 64;
#if SHADOW_EPI2 == 1
        if (u.sh) { float keep = 0.f;
#pragma unroll
            for (int ai = 0; ai < 2; ++ai)
#pragma unroll
                for (int bj = 0; bj < 2; ++bj)
#pragma unroll
                    for (int m = 0; m < 4; ++m)
#pragma unroll
                        for (int n = 0; n < 2; ++n) asm volatile("" :: "v"(acc[ai][bj][m][n]));
            return; }
#endif
        PG8_LAS unsigned char* patch = xl + (wr * 4 + wc) * 3072;
        if (pn < 2)      run<0>(acc, Q, 512, pn * 256 + cw, rowt, qg, qscale, fr, fq, patch);
        else if (pn < 4) run<0>(acc, Kb, 512, (pn - 2) * 256 + cw, rowt, kg, 1.0f, fr, fq, patch);
        else if (pn < 6) run<1>(acc, V, 512, (pn - 4) * 256 + cw, rowt, nullptr, 1.0f, fr, fq, patch);
        else if (pn < 8) run<1>(acc, U, 512, (pn - 6) * 256 + cw, rowt, nullptr, 1.0f, fr, fq, patch);
        else             run<2>(acc, SZ, 1024, (pn - 8) * 256 + cw, rowt, nullptr, 1.0f, fr, fq, patch);
    }
};
struct EpiOut {
    static constexpr bool PERM = true, AFTER_DRAIN = false, HEADPERM = true;
    const float* x; float* out; const float* modf; int seq; PG8_LAS unsigned char* xl;
    __device__ __forceinline__ void operator()(const f32x4 (&acc)[2][2][4][2], const Unit& u, int wr, int wc, int fr, int fq) const {
#if SHADOW_EPI4 == 1
        if (u.sh) {
#pragma unroll
            for (int ai = 0; ai < 2; ++ai)
#pragma unroll
                for (int bj = 0; bj < 2; ++bj)
#pragma unroll
                    for (int m = 0; m < 4; ++m)
#pragma unroll
                        for (int n = 0; n < 2; ++n) asm volatile("" :: "v"(acc[ai][bj][m][n]));
            return; }
#endif
        const int b = (u.pm * BM) / seq; const float* gate = modf + b * 3072 + 2048;
        const int lane = fq * 16 + fr, rr = lane >> 3, cc = lane & 7;
        const int col0 = u.pn * BM + wc * 64;
        PG8_LAS unsigned char* patch = xl + (wr * 4 + wc) * 3072;
        PG8_LAS unsigned char* wp = patch + fr * 144 + fq * 32;
        const PG8_LAS unsigned char* rp = patch + rr * 144 + cc * 16;
        f32x4 gv[2][2];
#pragma unroll
        for (int bj = 0; bj < 2; ++bj)
#pragma unroll
            for (int n = 0; n < 2; ++n) gv[bj][n] = *(const f32x4*)(gate + col0 + 8 * fq + 32 * bj + 4 * n);
#pragma unroll
        for (int ai = 0; ai < 2; ++ai) {
            const size_t rbase = (size_t)(u.pm * BM + ai * HALF + wr * 64) * 1024 + col0 + cc * 4;
            f32x4 xv[4][2][2];
#pragma unroll
            for (int m = 0; m < 4; ++m)
#pragma unroll
                for (int bj = 0; bj < 2; ++bj)
#pragma unroll
                    for (int i = 0; i < 2; ++i) xv[m][bj][i] = __builtin_nontemporal_load((const f32x4*)(x + rbase + (size_t)(m * 16 + rr + 8 * i) * 1024 + 32 * bj));
#pragma unroll
            for (int m = 0; m < 4; ++m)
#pragma unroll
                for (int bj = 0; bj < 2; ++bj) {
                    *(PG8_LAS f32x4*)(wp) = gv[bj][0] * acc[ai][bj][m][0]; *(PG8_LAS f32x4*)(wp + 16) = gv[bj][1] * acc[ai][bj][m][1];
                    const f32x4 t0 = *(const PG8_LAS f32x4*)(rp), t1 = *(const PG8_LAS f32x4*)(rp + 8 * 144);
                    __builtin_nontemporal_store(xv[m][bj][0] + t0, (f32x4*)(out + rbase + (size_t)(m * 16 + rr) * 1024 + 32 * bj));
                    __builtin_nontemporal_store(xv[m][bj][1] + t1, (f32x4*)(out + rbase + (size_t)(m * 16 + rr + 8) * 1024 + 32 * bj));
                }
            asm volatile("" ::: "memory");
        }
    }
};

template <class Epi, class Sched, bool ALIGN_EPI = false, bool SP2 = false>
__device__ __forceinline__ void gemm_phase(PG8_LAS unsigned char* lds, const Gemm g, const Sched& S, const Epi& E) {
    const int tid = threadIdx.x, wid = __builtin_amdgcn_readfirstlane(tid >> 6), lane = tid & 63, wr = wid >> 2, wc = wid & 3, fr = lane & 15, fq = lane >> 4;
    const int K = g.K, nt = K / BK;
    unsigned voffA[2], voffB[2];
#pragma unroll
    for (int i = 0; i < 2; ++i) { int R, C; stage_rc(tid * 16 + i * 8192, R, C); const int Rb = Epi::HEADPERM ? (64 * (R >> 5) + perm32(R & 31)) : (Epi::PERM ? ((R & ~31) + perm32(R & 31)) : R);
        voffA[i] = (unsigned)(R * K + C) * 2u; voffB[i] = (unsigned)(Rb * K + C) * 2u; }
    const size_t kstep = (size_t)(BK * 2);
    const size_t hstep = (size_t)HALF * K * 2;
    const size_t hstepB = Epi::HEADPERM ? (size_t)32 * K * 2 : hstep;
    const size_t tstep = 2 * hstep;
    const unsigned ldsw = (unsigned)wid * 1024u;
    const int aoff = lds_byte(wr * 64 + fr, fq * 8), boff = lds_byte(wc * 32 + fr, fq * 8);
#define PG8_SA(b, h) (((b) * 2 + (h)) * HTB)
#define PG8_SB(b, h) ((4 + (b) * 2 + (h)) * HTB)
#define PG8_STAGE(bufoff, gbase, voff) do { if (SHADOW_NODMA && cur.sh) break; _Pragma("unroll") for (int _i = 0; _i < 2; ++_i) \
        __builtin_amdgcn_global_load_lds((const unsigned*)((const char*)(gbase) + (voff)[_i]), (PG8_LAS unsigned*)(lds + (bufoff) + ldsw + _i * 8192), 16, 0, 0); } while (0)
#define PG8_LDA(dst, b, h) do { _Pragma("unroll") for (int m = 0; m < 4; ++m) _Pragma("unroll") for (int k = 0; k < 2; ++k) dst[m][k] = *(const PG8_LAS bf16x8*)(lds + PG8_SA(b, h) + aoff + m * 2048 + k * 1024); } while (0)
#define PG8_LDB(dst, b, h) do { _Pragma("unroll") for (int n = 0; n < 2; ++n) _Pragma("unroll") for (int k = 0; k < 2; ++k) dst[n][k] = *(const PG8_LAS bf16x8*)(lds + PG8_SB(b, h) + boff + n * 2048 + k * 1024); } while (0)
#define PG8_MMA(ai, bj, At, Bt) do { __builtin_amdgcn_s_setprio(1); _Pragma("unroll") for (int m = 0; m < 4; ++m) _Pragma("unroll") for (int n = 0; n < 2; ++n) _Pragma("unroll") for (int k = 0; k < 2; ++k) \
        acc[ai][bj][m][n] = __builtin_amdgcn_mfma_f32_16x16x32_bf16(Bt[n][k], At[m][k], acc[ai][bj][m][n], 0, 0, 0); __builtin_amdgcn_s_setprio(0); } while (0)
#define PG8_WAIT_V(n) asm volatile("s_waitcnt vmcnt(" #n ")" ::: "memory")
#define PG8_WAIT_L(n) asm volatile("s_waitcnt lgkmcnt(" #n ")" ::: "memory")
#define PG8_BAR __builtin_amdgcn_s_barrier()
#define PG8_SCHED __builtin_amdgcn_sched_barrier(0)
    Unit cur, nxt; int ui = 0;
    if (!S.next(0, cur)) return;
    f32x4 acc[2][2][4][2];
#pragma unroll
    for (int a = 0; a < 2; ++a)
#pragma unroll
        for (int b = 0; b < 2; ++b)
#pragma unroll
            for (int m = 0; m < 4; ++m)
#pragma unroll
                for (int n = 0; n < 2; ++n) acc[a][b][m][n] = (f32x4){0.f, 0.f, 0.f, 0.f};
    bf16x8 At[4][2], B0[2][2], B1[2][2];
    const char* cA = (const char*)g.A + (size_t)cur.pm * tstep; const char* cB = (const char*)g.Bt + (size_t)cur.pn * tstep;
    S.a_ready(cur);
    if constexpr (SP2) {
        PG8_STAGE(PG8_SB(0, 0), cB, voffB); PG8_STAGE(PG8_SB(0, 1), cB + hstepB, voffB); PG8_STAGE(PG8_SA(0, 0), cA, voffA); PG8_STAGE(PG8_SA(0, 1), cA + hstep, voffA);
        if (wr == 1) PG8_BAR;
        PG8_WAIT_V(2); PG8_BAR;
        PG8_STAGE(PG8_SB(1, 0), cB + kstep, voffB); PG8_STAGE(PG8_SA(1, 0), cA + kstep, voffA); PG8_STAGE(PG8_SB(1, 1), cB + hstepB + kstep, voffB);
        PG8_WAIT_V(6); PG8_BAR;
    } else {
        PG8_STAGE(PG8_SB(0, 0), cB, voffB); PG8_STAGE(PG8_SA(0, 0), cA, voffA); PG8_STAGE(PG8_SB(0, 1), cB + hstepB, voffB); PG8_STAGE(PG8_SA(0, 1), cA + hstep, voffA);
        if (wr == 1) PG8_BAR;
        PG8_WAIT_V(4); PG8_BAR;
        PG8_STAGE(PG8_SB(1, 0), cB + kstep, voffB); PG8_STAGE(PG8_SA(1, 0), cA + kstep, voffA); PG8_STAGE(PG8_SB(1, 1), cB + hstepB + kstep, voffB);
        PG8_WAIT_V(6); PG8_BAR;
    }
    for (;;) {
        const bool has_next = S.next(ui + 1, nxt);
        const char* nA = has_next ? (const char*)g.A + (size_t)nxt.pm * tstep : cA; const char* nB = has_next ? (const char*)g.Bt + (size_t)nxt.pn * tstep : cB;
        for (int t = 0; t < nt; t += 2) {
            const bool last = (t == nt - 2);
            const char* a1 = cA + (size_t)(t + 1) * kstep;
            const char* a2 = last ? nA : cA + (size_t)(t + 2) * kstep; const char* b2 = last ? nB : cB + (size_t)(t + 2) * kstep;
            const char* a3 = a2 + kstep; const char* b3 = b2 + kstep;
            if (last && has_next) S.a_ready(nxt);
            if constexpr (SP2) {
            PG8_LDB(B0, 0, 0); PG8_LDB(B1, 0, 1); PG8_SCHED; PG8_LDA(At, 0, 0); PG8_STAGE(PG8_SA(1, 1), a1 + hstep, voffA);
            PG8_WAIT_V(8); PG8_WAIT_L(0); PG8_BAR; PG8_MMA(0, 0, At, B0); PG8_MMA(0, 1, At, B1); PG8_BAR; PG8_SCHED;
            PG8_LDA(At, 0, 1); PG8_STAGE(PG8_SB(0, 0), b2, voffB); PG8_STAGE(PG8_SB(0, 1), b2 + hstepB, voffB); PG8_STAGE(PG8_SA(0, 0), a2, voffA);
            PG8_WAIT_V(8); PG8_WAIT_L(0); PG8_BAR; PG8_MMA(1, 0, At, B0); PG8_MMA(1, 1, At, B1); PG8_BAR; PG8_SCHED;
            PG8_LDB(B0, 1, 0); PG8_LDB(B1, 1, 1); PG8_SCHED; PG8_LDA(At, 1, 0); PG8_STAGE(PG8_SA(0, 1), a2 + hstep, voffA);
            PG8_WAIT_V(8); PG8_WAIT_L(0); PG8_BAR; PG8_MMA(0, 0, At, B0); PG8_MMA(0, 1, At, B1); PG8_BAR; PG8_SCHED;
            PG8_LDA(At, 1, 1); PG8_STAGE(PG8_SB(1, 0), b3, voffB); PG8_STAGE(PG8_SB(1, 1), b3 + hstepB, voffB); PG8_STAGE(PG8_SA(1, 0), a3, voffA);
            PG8_WAIT_V(8); PG8_WAIT_L(0); PG8_BAR; PG8_MMA(1, 0, At, B0); PG8_MMA(1, 1, At, B1); PG8_BAR; PG8_SCHED;
            } else {
            PG8_LDB(B0, 0, 0); PG8_SCHED; PG8_LDA(At, 0, 0); PG8_STAGE(PG8_SA(1, 1), a1 + hstep, voffA);
            PG8_WAIT_L(8); PG8_BAR; PG8_WAIT_L(0); PG8_MMA(0, 0, At, B0); PG8_BAR; PG8_SCHED;
            PG8_LDB(B1, 0, 1); PG8_STAGE(PG8_SB(0, 0), b2, voffB);
            PG8_BAR; PG8_WAIT_L(0); PG8_MMA(0, 1, At, B1); PG8_BAR;
            PG8_LDA(At, 0, 1); PG8_STAGE(PG8_SA(0, 0), a2, voffA);
            PG8_BAR; PG8_WAIT_L(0); PG8_MMA(1, 0, At, B0); PG8_BAR; PG8_SCHED;
            PG8_STAGE(PG8_SB(0, 1), b2 + hstepB, voffB);
            PG8_WAIT_V(6); PG8_BAR; PG8_MMA(1, 1, At, B1); PG8_BAR;
            PG8_LDB(B0, 1, 0); PG8_SCHED; PG8_LDA(At, 1, 0); PG8_STAGE(PG8_SA(0, 1), a2 + hstep, voffA);
            PG8_WAIT_L(8); PG8_BAR; PG8_WAIT_L(0); PG8_MMA(0, 0, At, B0); PG8_BAR; PG8_SCHED;
            PG8_LDB(B1, 1, 1); PG8_STAGE(PG8_SB(1, 0), b3, voffB);
            PG8_BAR; PG8_WAIT_L(0); PG8_MMA(0, 1, At, B1); PG8_BAR;
            PG8_LDA(At, 1, 1); PG8_STAGE(PG8_SA(1, 0), a3, voffA);
            PG8_BAR; PG8_WAIT_L(0); PG8_MMA(1, 0, At, B0); PG8_BAR; PG8_SCHED;
            PG8_STAGE(PG8_SB(1, 1), b3 + hstepB, voffB);
            PG8_WAIT_V(6); PG8_BAR; PG8_MMA(1, 1, At, B1); PG8_BAR;
            }
        }
        if constexpr (ALIGN_EPI) { if (wr == 0) PG8_BAR; }
        if constexpr (!Epi::AFTER_DRAIN) { E(acc, cur, wr, wc, fr, fq); S.done(cur); }
        if (!has_next) break;
#pragma unroll
        for (int a = 0; a < 2; ++a)
#pragma unroll
            for (int b = 0; b < 2; ++b)
#pragma unroll
                for (int m = 0; m < 4; ++m)
#pragma unroll
                    for (int n = 0; n < 2; ++n) acc[a][b][m][n] = (f32x4){0.f, 0.f, 0.f, 0.f};
        cur = nxt; cA = nA; cB = nB; ++ui;
        if constexpr (ALIGN_EPI) { if (wr == 1) PG8_BAR; }
    }
    PG8_WAIT_V(0);
    if constexpr (!ALIGN_EPI) { if (wr == 0) PG8_BAR; }
    PG8_BAR;
    if constexpr (Epi::AFTER_DRAIN) { E.fused(acc, cur, wr, wc, fr, fq, lds, wid, lane); S.done(cur); }
#undef PG8_SA
#undef PG8_SB
#undef PG8_STAGE
#undef PG8_LDA
#undef PG8_LDB
#undef PG8_MMA
#undef PG8_WAIT_V
#undef PG8_WAIT_L
#undef PG8_BAR
#undef PG8_SCHED
}
}
#ifndef PG8_SP2
#define PG8_SP2 true
#endif
#ifndef PG8_ALIGN
#define PG8_ALIGN true
#endif
namespace att {
using bf16 = __hip_bfloat16;
using bf16x8 = __attribute__((ext_vector_type(8))) short;
using s16x4 = __attribute__((ext_vector_type(4))) short;
using f32x16 = __attribute__((ext_vector_type(16))) float;
using f32x4 = __attribute__((ext_vector_type(4))) float;
using u32x4 = __attribute__((ext_vector_type(4))) unsigned;
#define ALAS __attribute__((address_space(3)))
typedef ALAS const char* lds_cptr;
typedef short v4i16_t __attribute__((ext_vector_type(4)));
constexpr int NSLOT = 6, SLOTB = 16384, VOFF = 8192;
constexpr int TB_COPY = 656, TB_FLOATS = 4 * TB_COPY, TBG_STRIDE = 2688, TB_ORG = 576;
constexpr int L_RING = 0, L_TB = NSLOT * SLOTB, L_WS = L_TB + TB_FLOATS * 4, L_OST = L_WS + 2048, L_END = L_OST + 8 * 4096;
constexpr int UNIT_ROWS = 256, NUNITS = BATCH * NHEAD * (SEQ / UNIT_ROWS);
__device__ __forceinline__ int crow(int r, int hi) { return (r & 3) + 8 * (r >> 2) + 4 * hi; }
__device__ __forceinline__ void glds16(const void* gsrc, unsigned lds_dst) { unsigned keep;
    asm volatile("s_mov_b32 %0, m0\n\ts_mov_b32 m0, %2\n\ts_nop 0\n\tglobal_load_lds_dwordx4 %1, off\n\ts_mov_b32 m0, %0" : "=&s"(keep) : "v"(gsrc), "s"(lds_dst) : "memory"); }
typedef float f32x2_t __attribute__((ext_vector_type(2))); typedef __bf16 bf16x2_t __attribute__((ext_vector_type(2)));
__device__ __forceinline__ unsigned cvtpk_s(float lo, float hi) { f32x2_t v = {lo, hi}; bf16x2_t b = __builtin_convertvector(v, bf16x2_t); return __builtin_bit_cast(unsigned, b); }
__device__ __forceinline__ s16x4 vtr(lds_cptr p) { return __builtin_bit_cast(s16x4, __builtin_amdgcn_ds_read_tr16_b64_v4i16((ALAS v4i16_t*)p)); }
__device__ __forceinline__ float bf_lo(unsigned w) { return __builtin_bit_cast(float, w << 16); }
__device__ __forceinline__ float bf_hi(unsigned w) { return __builtin_bit_cast(float, w & 0xffff0000u); }
#define ATT_WAIT_BAR(N) asm volatile("s_waitcnt vmcnt(" #N ") lgkmcnt(0)\n\ts_barrier" ::: "memory")
#define ATT_MFMA(a, b, c) __builtin_amdgcn_mfma_f32_32x32x16_bf16(a, b, c, 0, 0, 0)

struct Tensors { const bf16* Q; const bf16* K; const bf16* V; const bf16* U; const bf16* SZ; bf16* Y; const float* tbg; };

__device__ __forceinline__ void load_zq(u32x4 (&zq)[4], const Tensors& T, long qrow0, int h, int lane) {
#pragma unroll
    for (int i = 0; i < 4; ++i) zq[i] = __builtin_nontemporal_load((const u32x4*)(T.SZ + (size_t)(qrow0 + i * 8 + (lane >> 3)) * 1024 + h * 64 + (lane & 7) * 8));
}
__device__ __forceinline__ void unit_epilogue(float lsum, const f32x16& o0, const f32x16& o1, long qrow0, int h, int wid, int lane, int r32, int hi, const Tensors& T, lds_cptr l3, const u32x4 (&zq)[4]) {
    { auto rr = __builtin_amdgcn_permlane32_swap(__float_as_uint(lsum), __float_as_uint(lsum), false, false); lsum = __uint_as_float(rr[0]) + __uint_as_float(rr[1]); }
    ALAS float* wsf = (ALAS float*)(l3 + L_WS) + wid * 64;
    if (hi == 0) wsf[r32] = lsum;
    asm volatile("s_waitcnt lgkmcnt(0)" ::: "memory");
    float rli[16];
#pragma unroll
    for (int r = 0; r < 16; ++r) rli[r] = __builtin_amdgcn_rcpf(wsf[crow(r, hi)]);
    ALAS unsigned short* stg = (ALAS unsigned short*)(l3 + L_OST) + wid * 2048;
#pragma unroll
    for (int r = 0; r < 16; ++r) { const int orow = crow(r, hi);
        stg[orow * 64 + r32] = (unsigned short)(cvtpk_s(o0[r] * rli[r], 0.f) & 0xffffu);
        stg[orow * 64 + 32 + r32] = (unsigned short)(cvtpk_s(o1[r] * rli[r], 0.f) & 0xffffu); }
    asm volatile("s_waitcnt lgkmcnt(0)" ::: "memory");
    {
#pragma unroll
      for (int i = 0; i < 4; ++i) { const int row = i * 8 + (lane >> 3), ch = lane & 7;
        const u32x4 v = *(const ALAS u32x4*)(stg + row * 64 + ch * 8);
        const size_t go = (size_t)(qrow0 + row) * 1024 + h * 64 + ch * 8;
        u32x4 w;
#pragma unroll
        for (int j = 0; j < 4; ++j) w[j] = cvtpk_s(bf_lo(v[j]) * bf_lo(zq[i][j]), bf_hi(v[j]) * bf_hi(zq[i][j]));
        *(u32x4*)(T.Y + go) = w; } }
    asm volatile("s_waitcnt lgkmcnt(0)\n\ts_barrier" ::: "memory");
}

__device__ __forceinline__ void attn_unit(int b, int h, int m4, const Tensors& T, char* lds) {
    int tid = threadIdx.x; asm volatile("" : "+v"(tid));
    const int lane = tid & 63, r32 = lane & 31, hi = lane >> 5;
    const int wid = __builtin_amdgcn_readfirstlane(tid >> 6), grp = wid >> 1, hf = wid & 1;
    const long rowbase = (long)b * SEQ;
    const int c = 4 * m4 + grp;
    const long qrow0 = rowbase + 64 * c + 32 * hf;
    const unsigned lds0 = (unsigned)(uintptr_t)lds;
    const lds_cptr l3 = (lds_cptr)lds;
    const float* tg = T.tbg + h * TBG_STRIDE;
    for (int i = tid; i < TB_FLOATS / 4; i += 512) ((ALAS f32x4*)(l3 + L_TB))[i] = ((const f32x4*)tg)[i];
    const float cfar = tg[TB_FLOATS];
    const bf16* Qw = T.Q + (qrow0 + r32) * 512 + h * 64 + hi * 8;
    bf16x8 qr[4];
#pragma unroll
    for (int d0 = 0; d0 < 4; ++d0) qr[d0] = *reinterpret_cast<const bf16x8*>(Qw + d0 * 16);
    const bf16* ksrc = T.K + (rowbase + lane) * 512 + h * 64 + wid * 8;
    const bf16* vsrc = T.V + (rowbase + 16 * (wid & 3) + (lane >> 2)) * 512 + h * 64 + (wid >> 2) * 32 + (lane & 3) * 8;
    const unsigned kdst = lds0 + L_RING + wid * 1024, vdst = kdst + VOFF;
#define ATT_DMA(i) do { int tau_ = 4 * m4 - 8 + (i); tau_ = tau_ < 0 ? 0 : tau_; const unsigned so_ = (unsigned)(((i) % NSLOT) * SLOTB); \
        glds16(ksrc + (long)tau_ * (64 * 512), (unsigned)__builtin_amdgcn_readfirstlane(kdst + so_)); glds16(vsrc + (long)tau_ * (64 * 512), (unsigned)__builtin_amdgcn_readfirstlane(vdst + so_)); } while (0)
    const int k0 = (m4 == 0) ? 5 : (m4 == 1 ? 1 : 0);
    ATT_DMA(k0); ATT_DMA(k0 + 1); ATT_DMA(k0 + 2); ATT_DMA(k0 + 3); ATT_DMA(k0 + 4);
    const int s = (4 - (r32 & 3)) & 3;
    const int e0 = TB_ORG - 32 * hf - r32 + 4 * hi - s;
    const lds_cptr tb0 = l3 + L_TB + s * (TB_COPY * 4) + e0 * 4;
    const lds_cptr kp0 = l3 + L_RING + hi * 1024 + r32 * 16;
    const lds_cptr vp0 = l3 + L_RING + VOFF + ((lane >> 4) & 1) * 32 + (lane & 3) * 8 + (4 * hi + ((lane & 15) >> 2)) * 64;
    f32x16 o0 = f32x16{}, o1 = f32x16{}; float lsum = 0.f;
    f32x16 cf;
#pragma unroll
    for (int r = 0; r < 16; ++r) cf[r] = cfar;
    asm volatile("" : "+v"(cf));
#pragma unroll 1
    for (int k = k0; k < 9; ++k) {
        if (k < 8) ATT_WAIT_BAR(2); else ATT_WAIT_BAR(0);
        if (k + 5 < 12) ATT_DMA(k + 5);
        const int Tt = 4 * m4 + grp - 8 + k;
        if (Tt >= 0) {
            const int so = ((k + grp) % NSLOT) * SLOTB;
            const lds_cptr kp = kp0 + so;
            bf16x8 kf[8];
#pragma unroll
            for (int d0 = 0; d0 < 4; ++d0) { kf[2 * d0] = *(const ALAS bf16x8*)(kp + d0 * 2048); kf[2 * d0 + 1] = *(const ALAS bf16x8*)(kp + d0 * 2048 + 512); }
            f32x16 p0, p1;
            if (k >= 4) {
                const lds_cptr tp = tb0 - 256 * (8 - k);
#pragma unroll
                for (int g = 0; g < 4; ++g) { const f32x4 a = *(const ALAS f32x4*)(tp + 32 * g), bq = *(const ALAS f32x4*)(tp + 32 * (g + 4));
#pragma unroll
                    for (int j = 0; j < 4; ++j) { p0[4 * g + j] = a[j]; p1[4 * g + j] = bq[j]; } }
            } else { p0 = cf; p1 = cf; }
#pragma unroll
            for (int d0 = 0; d0 < 4; ++d0) { p0 = ATT_MFMA(kf[2 * d0], qr[d0], p0); p1 = ATT_MFMA(kf[2 * d0 + 1], qr[d0], p1); }
#pragma unroll
            for (int r = 0; r < 16; ++r) { p0[r] = __builtin_amdgcn_exp2f(p0[r]); p1[r] = __builtin_amdgcn_exp2f(p1[r]); }
            float sa = 0.f, sb = 0.f;
#pragma unroll
            for (int r = 0; r < 16; ++r) { sa += p0[r]; sb += p1[r]; }
            lsum += sa + sb;
            u32x4 pw0, pw1, pw2, pw3;
#define ATT_PKW(P, B) cvtpk_s(P[B], P[(B) + 1])
            pw0 = (u32x4){ATT_PKW(p0, 0), ATT_PKW(p0, 2), ATT_PKW(p0, 4), ATT_PKW(p0, 6)}; pw1 = (u32x4){ATT_PKW(p0, 8), ATT_PKW(p0, 10), ATT_PKW(p0, 12), ATT_PKW(p0, 14)};
            pw2 = (u32x4){ATT_PKW(p1, 0), ATT_PKW(p1, 2), ATT_PKW(p1, 4), ATT_PKW(p1, 6)}; pw3 = (u32x4){ATT_PKW(p1, 8), ATT_PKW(p1, 10), ATT_PKW(p1, 12), ATT_PKW(p1, 14)};
#undef ATT_PKW
            const lds_cptr vp = vp0 + so;
#define ATT_VFR(d0, ks) ({ const s16x4 lo_ = vtr(vp + (d0) * 4096 + (ks) * 1024), hi_ = vtr(vp + (d0) * 4096 + (ks) * 1024 + 512); (bf16x8){lo_[0], lo_[1], lo_[2], lo_[3], hi_[0], hi_[1], hi_[2], hi_[3]}; })
            o0 = ATT_MFMA(__builtin_bit_cast(bf16x8, pw0), ATT_VFR(0, 0), o0); o1 = ATT_MFMA(__builtin_bit_cast(bf16x8, pw0), ATT_VFR(1, 0), o1);
            o0 = ATT_MFMA(__builtin_bit_cast(bf16x8, pw1), ATT_VFR(0, 1), o0); o1 = ATT_MFMA(__builtin_bit_cast(bf16x8, pw1), ATT_VFR(1, 1), o1);
            o0 = ATT_MFMA(__builtin_bit_cast(bf16x8, pw2), ATT_VFR(0, 2), o0); o1 = ATT_MFMA(__builtin_bit_cast(bf16x8, pw2), ATT_VFR(1, 2), o1);
            o0 = ATT_MFMA(__builtin_bit_cast(bf16x8, pw3), ATT_VFR(0, 3), o0); o1 = ATT_MFMA(__builtin_bit_cast(bf16x8, pw3), ATT_VFR(1, 3), o1);
#undef ATT_VFR
        }
    }
#undef ATT_DMA
    { u32x4 zq[4]; load_zq(zq, T, qrow0, h, lane); unit_epilogue(lsum, o0, o1, qrow0, h, wid, lane, r32, hi, T, l3, zq); }
}

#define P_SBAR() __builtin_amdgcn_sched_barrier(0)
#define P_PIN(x) asm volatile("" : "+v"(x))
#define P_EX(v) __builtin_amdgcn_exp2f(v)
constexpr int PK_RING = 0, PV_RING = 49152, PSLOT = 8192;
template <int VAR> __device__ __forceinline__ void attn_run_p(int b, int h, int m4s, int n, const Tensors& T, char* lds) {
#define P_WB(N) do { if (VAR == 3) { asm volatile("s_waitcnt vmcnt(" #N ") lgkmcnt(0)" ::: "memory"); } else { ATT_WAIT_BAR(N); } } while (0)
    const unsigned lds0 = (unsigned)(uintptr_t)lds;
    const lds_cptr l3 = (lds_cptr)lds;
    const long rowbase = (long)b * SEQ;
    { const float* tg = T.tbg + h * TBG_STRIDE;
      for (int i = threadIdx.x; i < TB_FLOATS / 4; i += 512) ((ALAS f32x4*)(l3 + L_TB))[i] = ((const f32x4*)tg)[i]; }
#define P_DMAK(i) do { if (VAR != 2) glds16(kptr, (unsigned)__builtin_amdgcn_readfirstlane(kdst + (unsigned)(((i) % 6) * PSLOT))); kptr += 64 * 512; asm volatile("" : "+v"(kptr)); } while (0)
#define P_DMAV(i) do { if (VAR != 2) glds16(vptr, (unsigned)__builtin_amdgcn_readfirstlane(vdst + (unsigned)(((i) % 6) * PSLOT))); vptr += 64 * 512; asm volatile("" : "+v"(vptr)); } while (0)
    const bf16* kptr; const bf16* vptr; bf16x8 qr[4];
    { const int tid0 = threadIdx.x, lane = tid0 & 63, r32 = lane & 31, hi = lane >> 5; const int wid = __builtin_amdgcn_readfirstlane(tid0 >> 6), grp = wid >> 1, hf = wid & 1;
      const unsigned kdst = lds0 + PK_RING + wid * 1024, vdst = lds0 + PV_RING + wid * 1024;
      kptr = T.K + (rowbase + (long)(4 * m4s - 8) * 64 + 8 * wid + (lane >> 3)) * 512 + h * 64 + (((lane & 7) ^ ((lane >> 3) & 7)) * 8);
      vptr = T.V + (rowbase + (long)(4 * m4s - 8) * 64 + 8 * wid + (lane >> 3)) * 512 + h * 64 + ((((lane >> 2) & 1) ^ ((lane >> 4) & 1)) * 32) + (lane & 3) * 8;
      P_DMAK(0); P_DMAK(1); P_DMAK(2); P_DMAK(3); P_DMAK(4); P_DMAK(5); P_DMAV(0); P_DMAV(1);
      const bf16* Qw = T.Q + (rowbase + 64 * (4 * m4s + grp) + 32 * hf + r32) * 512 + h * 64 + hi * 8;
#pragma unroll
      for (int d0 = 0; d0 < 4; ++d0) qr[d0] = *reinterpret_cast<const bf16x8*>(Qw + d0 * 16); }
#pragma unroll 1
  for (int u = 0; u < n; ++u) {
    const int m4 = m4s + u;
    int tid = threadIdx.x; asm volatile("" : "+v"(tid));
    const int lane = tid & 63, r32 = lane & 31, hi = lane >> 5;
    const int wid = __builtin_amdgcn_readfirstlane(tid >> 6), grp = wid >> 1, hf = wid & 1;
    const int c = 4 * m4 + grp;
    const long qrow0 = rowbase + 64 * c + 32 * hf;
    const unsigned kdst = lds0 + PK_RING + wid * 1024, vdst = lds0 + PV_RING + wid * 1024;
    P_DMAV(2); P_DMAV(3);
    const int s = (4 - (r32 & 3)) & 3;
    const int e0 = TB_ORG - 32 * hf - r32 + 4 * hi - s;
    const lds_cptr tb0 = l3 + L_TB + s * (TB_COPY * 4) + e0 * 4;
    const lds_cptr kp0 = l3 + PK_RING + r32 * 128; const int ksw = r32 & 7;
#define P_KOFF(d0) ((((2 * (d0) + hi) ^ ksw) << 4))
    const lds_cptr vp0 = l3 + PV_RING + ((lane >> 4) & 1) * 32 + (lane & 3) * 8 + (4 * hi + ((lane & 15) >> 2)) * 128; const int vsw = ((lane >> 3) & 1) * 64;
    f32x16 o0 = f32x16{}, o1 = f32x16{}; float lsum = 0.f;
    f32x16 pA0, pA1, pB0, pB1; bf16x8 kf[8]; s16x4 vlo[4], vhi[4]; u32x4 pw0, pw1, pw2, pw3; lds_cptr vp_ = vp0;
    P_WB(1);
    { const lds_cptr kp = kp0 + (grp % 6) * PSLOT;
#pragma unroll
      for (int d0 = 0; d0 < 4; ++d0) { kf[2 * d0] = *(const ALAS bf16x8*)(kp + P_KOFF(d0)); kf[2 * d0 + 1] = *(const ALAS bf16x8*)(kp + P_KOFF(d0) + 4096); } }
#define P_PKW(P, B) cvtpk_s(P[B], P[(B) + 1])
#define P_PAF(k) __builtin_bit_cast(bf16x8, pw##k)
#define P_VFR(j) (bf16x8){vlo[j][0], vlo[j][1], vlo[j][2], vlo[j][3], vhi[j][0], vhi[j][1], vhi[j][2], vhi[j][3]}
#define P_VRD(j, i) do { if (VAR != 6) { vlo[j] = vtr(vp_ + (((((i) >> 2) * 64) ^ vsw) + ((i) & 3) * 2048)); vhi[j] = vtr(vp_ + (((((i) >> 2) * 64) ^ vsw) + ((i) & 3) * 2048 + 1024)); } } while (0)
#define P_KRD(G, j) do { if ((G) && VAR != 5) { kf[2 * (j)] = *(const ALAS bf16x8*)(kn_ + P_KOFF(j)); kf[2 * (j) + 1] = *(const ALAS bf16x8*)(kn_ + P_KOFF(j) + 4096); P_SBAR(); } } while (0)
#define P_TRD(G, X0, X1, g) do { if ((G) && VAR != 4) { const f32x4 ta_ = *(const ALAS f32x4*)(tn_ + 32 * (g)), tb_ = *(const ALAS f32x4*)(tn_ + 32 * ((g) + 4)); \
        X0[4 * (g)] = ta_[0]; X0[4 * (g) + 1] = ta_[1]; X0[4 * (g) + 2] = ta_[2]; X0[4 * (g) + 3] = ta_[3]; X1[4 * (g)] = tb_[0]; X1[4 * (g) + 1] = tb_[1]; X1[4 * (g) + 2] = tb_[2]; X1[4 * (g) + 3] = tb_[3]; P_SBAR(); } } while (0)
#define P_GAPA(MF, A0, A1, A2, A3, W0, W1, PW) do { MF; if (VAR != 7) { sacc += A0; sacc += A1; sacc += A2; sacc += A3; P_PIN(sacc); W0; W1; P_PIN(PW); } P_SBAR(); } while (0)
#define P_GAPB(MF, X, B) do { MF; if (VAR != 1) { X[B] = P_EX(X[B]); X[(B) + 1] = P_EX(X[(B) + 1]); X[(B) + 2] = P_EX(X[(B) + 2]); X[(B) + 3] = P_EX(X[(B) + 3]); } P_PIN(X); P_SBAR(); } while (0)
#define P_PHASE_A(C0, C1, CI0, CI1, P0, P1, k, HASP) do { P_SBAR(); \
    vp_ = vp0 + (((k) + 5 + grp) % 6) * PSLOT; float sacc = 0.f; \
    if (HASP) { sacc = P0[0] + P0[1]; } \
    if (HASP) P_GAPA(C0 = ATT_MFMA(kf[0], qr[0], CI0), P0[2], P0[3], P0[4], P0[5], pw0[0] = P_PKW(P0, 0), pw0[1] = P_PKW(P0, 2), pw0); else { C0 = ATT_MFMA(kf[0], qr[0], CI0); P_SBAR(); } \
    if (HASP) { P_GAPA(C1 = ATT_MFMA(kf[1], qr[0], CI1), P0[6], P0[7], P0[8], P0[9], pw0[2] = P_PKW(P0, 4), pw0[3] = P_PKW(P0, 6), pw0); } else { C1 = ATT_MFMA(kf[1], qr[0], CI1); P_SBAR(); } \
    if (HASP) { P_GAPA(C0 = ATT_MFMA(kf[2], qr[1], C0), P0[10], P0[11], P0[12], P0[13], pw1[0] = P_PKW(P0, 8), pw1[1] = P_PKW(P0, 10), pw1); } else { C0 = ATT_MFMA(kf[2], qr[1], C0); P_SBAR(); } \
    if (HASP) { P_GAPA(C1 = ATT_MFMA(kf[3], qr[1], C1), P0[14], P0[15], P1[0], P1[1], pw1[2] = P_PKW(P0, 12), pw1[3] = P_PKW(P0, 14), pw1); } else { C1 = ATT_MFMA(kf[3], qr[1], C1); P_SBAR(); } \
    if (HASP) { P_VRD(0, 0); P_SBAR(); P_GAPA(C0 = ATT_MFMA(kf[4], qr[2], C0), P1[2], P1[3], P1[4], P1[5], pw2[0] = P_PKW(P1, 0), pw2[1] = P_PKW(P1, 2), pw2); } else { C0 = ATT_MFMA(kf[4], qr[2], C0); P_SBAR(); } \
    if (HASP) { P_VRD(1, 4); P_SBAR(); P_GAPA(C1 = ATT_MFMA(kf[5], qr[2], C1), P1[6], P1[7], P1[8], P1[9], pw2[2] = P_PKW(P1, 4), pw2[3] = P_PKW(P1, 6), pw2); } else { C1 = ATT_MFMA(kf[5], qr[2], C1); P_SBAR(); } \
    if (HASP) { P_VRD(2, 1); P_SBAR(); P_GAPA(C0 = ATT_MFMA(kf[6], qr[3], C0), P1[10], P1[11], P1[12], P1[13], pw3[0] = P_PKW(P1, 8), pw3[1] = P_PKW(P1, 10), pw3); } else { C0 = ATT_MFMA(kf[6], qr[3], C0); P_SBAR(); } \
    if (HASP) { P_VRD(3, 5); P_SBAR(); P_GAPA(C1 = ATT_MFMA(kf[7], qr[3], C1), P1[14], P1[15], 0.f, 0.f, pw3[2] = P_PKW(P1, 12), pw3[3] = P_PKW(P1, 14), pw3); } else { C1 = ATT_MFMA(kf[7], qr[3], C1); P_SBAR(); } \
    lsum += sacc; } while (0)
#define P_PHASE_B(C0, C1, N0, N1, k, HASP, GK, GT) do { \
    const lds_cptr kn_ = kp0 + (((k) + 1 + grp) % 6) * PSLOT; const lds_cptr tn_ = tb0 - 256 * (7 - (k)); \
    if (HASP) { P_GAPB(o0 = ATT_MFMA(P_PAF(0), P_VFR(0), o0), C0, 0); P_VRD(0, 2); P_SBAR(); } else P_GAPB((void)0, C0, 0); \
    if (HASP) { P_GAPB(o1 = ATT_MFMA(P_PAF(0), P_VFR(1), o1), C0, 4); P_VRD(1, 6); P_SBAR(); } else P_GAPB((void)0, C0, 4); \
    P_KRD(GK, 0); if (HASP) { P_GAPB(o0 = ATT_MFMA(P_PAF(1), P_VFR(2), o0), C0, 8); P_VRD(2, 3); P_SBAR(); } else P_GAPB((void)0, C0, 8); \
    P_KRD(GK, 1); if (HASP) { P_GAPB(o1 = ATT_MFMA(P_PAF(1), P_VFR(3), o1), C0, 12); P_VRD(3, 7); P_SBAR(); } else P_GAPB((void)0, C0, 12); \
    P_KRD(GK, 2); if (HASP) P_GAPB(o0 = ATT_MFMA(P_PAF(2), P_VFR(0), o0), C1, 0); else P_GAPB((void)0, C1, 0); \
    P_KRD(GK, 3); if (HASP) P_GAPB(o1 = ATT_MFMA(P_PAF(2), P_VFR(1), o1), C1, 4); else P_GAPB((void)0, C1, 4); \
    P_TRD(GT, N0, N1, 0); if (HASP) P_GAPB(o0 = ATT_MFMA(P_PAF(3), P_VFR(2), o0), C1, 8); else P_GAPB((void)0, C1, 8); \
    P_TRD(GT, N0, N1, 1); if (HASP) P_GAPB(o1 = ATT_MFMA(P_PAF(3), P_VFR(3), o1), C1, 12); else P_GAPB((void)0, C1, 12); \
    P_TRD(GT, N0, N1, 2); P_TRD(GT, N0, N1, 3); } while (0)
    { const lds_cptr tn_ = tb0 - 256 * 8; P_TRD(true, pA0, pA1, 0); P_TRD(true, pA0, pA1, 1); P_TRD(true, pA0, pA1, 2); P_TRD(true, pA0, pA1, 3); }
    P_PHASE_A(pA0, pA1, pA0, pA1, pB0, pB1, 0, false); P_DMAK(6); P_DMAV(4); P_PHASE_B(pA0, pA1, pB0, pB1, 0, false, true, true); P_WB(2);
#pragma unroll 1
    for (int k = 1; k <= 7; k += 2) {
        P_PHASE_A(pB0, pB1, pB0, pB1, pA0, pA1, k, true);      if (k + 6 <= 11) { P_DMAK(k + 6); } P_DMAV(k + 4); P_PHASE_B(pB0, pB1, pA0, pA1, k, true, true, true);
        if (k + 6 <= 11) P_WB(2); else P_WB(1);
        const bool more = k + 1 < 8;
        P_PHASE_A(pA0, pA1, pA0, pA1, pB0, pB1, k + 1, true);  if (k + 7 <= 11) { P_DMAK(k + 7); } if (k + 5 <= 11) { P_DMAV(k + 5); } P_PHASE_B(pA0, pA1, pB0, pB1, k + 1, true, more, more);
        if (k + 7 <= 11) P_WB(2); else if (k + 5 <= 11) P_WB(1); else P_WB(0);
    }
    bf16x8 qn[4]; u32x4 zq[4];
    if (u + 1 < n) { kptr -= 8 * 64 * 512; vptr -= 8 * 64 * 512;
      P_DMAK(0); P_DMAK(1); P_DMAK(2); P_DMAK(3); P_DMAK(4); P_DMAK(5); P_DMAV(0); P_DMAV(1);
      const bf16* Qn = T.Q + (qrow0 + 256 + r32) * 512 + h * 64 + hi * 8;
#pragma unroll
      for (int d0 = 0; d0 < 4; ++d0) qn[d0] = *reinterpret_cast<const bf16x8*>(Qn + d0 * 16); }
    load_zq(zq, T, qrow0, h, lane);
    { vp_ = vp0 + ((8 + grp) % 6) * PSLOT;
      P_VRD(0, 0); P_VRD(1, 4); P_VRD(2, 1); P_VRD(3, 5);
      float sacc = 0.f;
#pragma unroll
      for (int r = 0; r < 16; ++r) sacc += pA0[r] + pA1[r];
      lsum += sacc;
      pw0 = (u32x4){P_PKW(pA0, 0), P_PKW(pA0, 2), P_PKW(pA0, 4), P_PKW(pA0, 6)}; pw1 = (u32x4){P_PKW(pA0, 8), P_PKW(pA0, 10), P_PKW(pA0, 12), P_PKW(pA0, 14)};
      pw2 = (u32x4){P_PKW(pA1, 0), P_PKW(pA1, 2), P_PKW(pA1, 4), P_PKW(pA1, 6)}; pw3 = (u32x4){P_PKW(pA1, 8), P_PKW(pA1, 10), P_PKW(pA1, 12), P_PKW(pA1, 14)};
      o0 = ATT_MFMA(P_PAF(0), P_VFR(0), o0); o1 = ATT_MFMA(P_PAF(0), P_VFR(1), o1); o0 = ATT_MFMA(P_PAF(1), P_VFR(2), o0); o1 = ATT_MFMA(P_PAF(1), P_VFR(3), o1);
      P_SBAR(); P_VRD(0, 2); P_VRD(1, 6); P_VRD(2, 3); P_VRD(3, 7); P_SBAR();
      o0 = ATT_MFMA(P_PAF(2), P_VFR(0), o0); o1 = ATT_MFMA(P_PAF(2), P_VFR(1), o1); o0 = ATT_MFMA(P_PAF(3), P_VFR(2), o0); o1 = ATT_MFMA(P_PAF(3), P_VFR(3), o1); }
    if (VAR == 8) { asm volatile("" :: "v"(o0), "v"(o1), "v"(lsum), "v"(zq[0]), "v"(zq[1]), "v"(zq[2]), "v"(zq[3])); asm volatile("s_waitcnt lgkmcnt(0)\n\ts_barrier" ::: "memory"); }
    else unit_epilogue(lsum, o0, o1, qrow0, h, wid, lane, r32, hi, T, l3, zq);
    if (u + 1 < n) {
#pragma unroll
      for (int d0 = 0; d0 < 4; ++d0) qr[d0] = qn[d0]; }
  }
#undef P_DMAK
#undef P_DMAV
}

constexpr int POOL_R = 8;
template <int W> __device__ __forceinline__ void pool_item(int g, long rb, const Tensors& T, int lane) {
    const long row0 = rb + POOL_R * (lane >> 4); const int t0 = (int)(row0 % SEQ);
    const int col = g * 128 + (lane & 15) * 8;
    const bf16* up = T.U + row0 * 512 + col;
    float S[8];
#pragma unroll
    for (int j = 0; j < 8; ++j) S[j] = 0.f;
    if (W > 8) {
#pragma unroll
        for (int a = 9; a <= W; ++a) { const bool ok = t0 - a >= 0; const u32x4 v = *(const u32x4*)(up - (long)(ok ? a : 0) * 512); const float mk = ok ? 1.0f : 0.0f;
#pragma unroll
            for (int j = 0; j < 4; ++j) { S[2 * j] += mk * bf_lo(v[j]); S[2 * j + 1] += mk * bf_hi(v[j]); } }
#pragma unroll
        for (int j = 0; j < 8; ++j) asm volatile("" : "+v"(S[j]));
        asm volatile("" ::: "memory");
    }
    u32x4 nv[POOL_R], ov[POOL_R], zv[POOL_R];
#pragma unroll
    for (int r = 0; r < POOL_R; ++r) { nv[r] = *(const u32x4*)(up + (long)r * 512); zv[r] = __builtin_nontemporal_load((const u32x4*)(T.SZ + (size_t)(row0 + r) * 1024 + 512 + col));
        const bool ok = t0 + r - W >= 0; ov[r] = *(const u32x4*)(up + (long)(ok ? r - W : r) * 512); }
#pragma unroll
    for (int a = 1; a <= (W > 8 ? 8 : W); ++a) { const bool ok = t0 - a >= 0; const u32x4 v = *(const u32x4*)(up - (long)(ok ? a : 0) * 512); const float mk = ok ? 1.0f : 0.0f;
#pragma unroll
        for (int j = 0; j < 4; ++j) { S[2 * j] += mk * bf_lo(v[j]); S[2 * j + 1] += mk * bf_hi(v[j]); } }
#pragma unroll
    for (int r = 0; r < POOL_R; ++r) {
        const int t = t0 + r; const float mk = (t - W >= 0) ? 1.0f : 0.0f;
        const float ic = (t + 1 < W) ? 1.0f / (float)(t + 1) : 1.0f / (float)W;
        float nf[8];
#pragma unroll
        for (int j = 0; j < 4; ++j) { nf[2 * j] = bf_lo(nv[r][j]); nf[2 * j + 1] = bf_hi(nv[r][j]); S[2 * j] += nf[2 * j] - mk * bf_lo(ov[r][j]); S[2 * j + 1] += nf[2 * j + 1] - mk * bf_hi(ov[r][j]); }
        u32x4 o;
#pragma unroll
        for (int j = 0; j < 4; ++j) o[j] = cvtpk_s((S[2 * j] * ic - nf[2 * j]) * bf_lo(zv[r][j]), (S[2 * j + 1] * ic - nf[2 * j + 1]) * bf_hi(zv[r][j]));
        *(u32x4*)(T.Y + (size_t)(row0 + r) * 1024 + 512 + col) = o;
    }
}
constexpr int NPOOL_ITEMS = 4 * (MROWS / (4 * POOL_R));
__device__ __forceinline__ void pool_dispatch(int item, const Tensors& T, int lane) {
    const int g = item & 3; const long rb = (long)(item >> 2) * (4 * POOL_R);
    if (g == 0) pool_item<2>(g, rb, T, lane); else if (g == 1) pool_item<4>(g, rb, T, lane); else if (g == 2) pool_item<8>(g, rb, T, lane); else pool_item<16>(g, rb, T, lane);
}
}

#define GAS __attribute__((address_space(1)))
#define LAS __attribute__((address_space(3)))
typedef unsigned short bf16;
typedef unsigned v4u __attribute__((ext_vector_type(4)));
typedef float f32x4 __attribute__((ext_vector_type(4)));
typedef short bf16x8 __attribute__((ext_vector_type(8)));
typedef GAS unsigned gu32;
typedef GAS unsigned long long gu64;
#define RLX_AGENT __ATOMIC_RELAXED, __HIP_MEMORY_SCOPE_AGENT
#define LDS_WAIT() asm volatile("s_waitcnt lgkmcnt(0)" ::: "memory")
#define VM_WAIT() asm volatile("s_waitcnt vmcnt(0)" ::: "memory")
__device__ __forceinline__ unsigned long long rt() { return __builtin_amdgcn_s_memrealtime(); }
__device__ __forceinline__ unsigned f2bf(float f) { unsigned u = __builtin_bit_cast(unsigned, f); return (u + 0x7fffu + ((u >> 16) & 1u)) >> 16; }
__device__ __forceinline__ unsigned pk2(float lo, float hi) { return f2bf(lo) | (f2bf(hi) << 16); }

#define XB_TMO      128
#define XB_XCNT(j)  (256  + 64 * (j))
#define XB_XSUB(j)  (1280 + 64 * (j))
#define XB_XGEN(j)  (2304 + 64 * (j))
#define XB_TOP      3328
#define XB_TOPGEN   3392
#define XCD_BAR_WORDS 3456
#define XB_SPIN_CAP (1u << 18)

__device__ __forceinline__ unsigned xb_ld(unsigned* p)              { return __hip_atomic_load(p, __ATOMIC_RELAXED, __HIP_MEMORY_SCOPE_AGENT); }
__device__ __forceinline__ unsigned xb_add(unsigned* p, unsigned v) { return __hip_atomic_fetch_add(p, v, __ATOMIC_RELAXED, __HIP_MEMORY_SCOPE_AGENT); }
__device__ __forceinline__ unsigned xb_xcc_id() { return (unsigned)__builtin_amdgcn_s_getreg((3 << 11) | 20) & 0xFu; }
#define XB_SPIN(cond, bar) do { unsigned _sp = 0; while (cond) { __builtin_amdgcn_s_sleep(1); \
    if ((++_sp & 255u) == 0u) { if (xb_ld(&(bar)[XB_TMO])) break; if (_sp > XB_SPIN_CAP) { atomicAdd(&(bar)[XB_TMO], 1u); break; } } } } while (0)

struct XcdBarrier {
    unsigned* bar; unsigned x, expect;
    volatile LAS unsigned* st;
};

__device__ __forceinline__ XcdBarrier xcd_barrier_post(unsigned* bar, volatile LAS unsigned* st, unsigned expect) {
    XcdBarrier b; b.bar = bar; b.x = xb_xcc_id(); b.st = st; b.expect = expect;
    if (threadIdx.x == 0) (void)xb_add(&bar[XB_XCNT(b.x)], 1u);
    return b;
}
__device__ __forceinline__ void xcd_barrier_complete(unsigned* bar, unsigned x, unsigned& nloc, unsigned& nx, unsigned G) {
    unsigned sum, cnt, mine, sp = 0u;
    for (;;) {
        sum = 0u; cnt = 0u; mine = 0u;
#pragma unroll
        for (unsigned j = 0; j < 16; ++j) { const unsigned c = xb_ld(&bar[XB_XCNT(j)]); sum += c; cnt += (c > 0u) ? 1u : 0u; mine = (j == x) ? c : mine; }
        if (sum == G) break;
        __builtin_amdgcn_s_sleep(1);
        if ((++sp & 255u) == 0u) { if (xb_ld(&bar[XB_TMO])) break; if (sp > XB_SPIN_CAP) { atomicAdd(&bar[XB_TMO], 1u); break; } }
    }
    nloc = mine > 0u ? mine : 1u; nx = cnt > 0u ? cnt : 1u;
}

__device__ __forceinline__ void xcd_barrier(const XcdBarrier& b) {
    asm volatile("s_waitcnt vmcnt(0)" ::: "memory");
    __syncthreads();
    if (threadIdx.x == 0) {
        unsigned* bar = b.bar;
        __builtin_amdgcn_s_waitcnt(0);
        unsigned nloc = b.st[0], nx = b.st[1];
        if (nloc == 0u) { xcd_barrier_complete(bar, b.x, nloc, nx, b.expect); b.st[0] = nloc; b.st[1] = nx; }
        const unsigned old = xb_add(&bar[XB_XSUB(b.x)], 1u);
        const unsigned gen = old / nloc;
        if (old + 1u == (gen + 1u) * nloc) {
            __builtin_amdgcn_fence(__ATOMIC_RELEASE, "agent");
            asm volatile("s_waitcnt vmcnt(0)" ::: "memory");
            const unsigned og = xb_add(&bar[XB_TOP], 1u);
            const unsigned tg = og / nx;
            if (og + 1u == (tg + 1u) * nx) xb_add(&bar[XB_TOPGEN], 1u);
            else XB_SPIN(xb_ld(&bar[XB_TOPGEN]) == tg, bar);
            __builtin_amdgcn_fence(__ATOMIC_ACQUIRE, "agent");
            xb_add(&bar[XB_XGEN(b.x)], 1u);
            asm volatile("s_waitcnt vmcnt(0)" ::: "memory");
        } else {
            XB_SPIN(xb_ld(&bar[XB_XGEN(b.x)]) == gen, bar);
            __builtin_amdgcn_fence(__ATOMIC_ACQUIRE, "agent");
            asm volatile("s_waitcnt vmcnt(0)" ::: "memory");
        }
    }
    __syncthreads();
}

constexpr int NWAVES = 8;
#ifndef MK_N_LAUNCHES
#define MK_N_LAUNCHES 1
#endif
constexpr int N_LAUNCHES = MK_N_LAUNCHES;
constexpr int PER_PHASE = 5;
constexpr size_t MiB = 1u << 20;
constexpr size_t WS_CTL = 0, CTL_ZERO_BYTES = 128 * 1024;
constexpr size_t WS_MOD = 1 * MiB;
constexpr size_t WS_MODP = 1 * MiB + 256 * 1024;
constexpr size_t WS_TBG = 1 * MiB + 64 * 1024;
constexpr size_t WS_WIN = 2 * MiB, WS_WOUT = 8 * MiB;
constexpr size_t WS_XN = 16 * MiB;
constexpr size_t WS_Q = 80 * MiB, WS_K = 112 * MiB, WS_V = 144 * MiB, WS_U = 176 * MiB;
constexpr size_t WS_SZ = 208 * MiB, WS_Y = 272 * MiB, WS_END = 336 * MiB;
constexpr int CW_TMO = 0, CW_MODCNT = 64, CW_BAR = 4096;
constexpr int PHASE_BYTES = 155648;
constexpr int LDSCTL_OFF = PHASE_BYTES, LDS_BYTES = PHASE_BYTES + 512;
static_assert(att::L_END <= PHASE_BYTES && pg8::STAGE_BYTES + 8 * 3072 <= PHASE_BYTES && LDS_BYTES <= 163840, "LDS map");

struct Frame {
    LAS unsigned char* lds; volatile LAS unsigned* MISC; gu32* ctl;
    int tid, lane, wave, vcu, G;
    const float *x, *c, *norm_g, *w_ada, *b_ada, *w_in, *qg, *kg, *rel_bias, *w_pool, *pool_scale, *w_out; float* out;
    float *modf, *modp, *tbg; bf16 *Wt_in, *Wt_out, *XN, *Qb, *Kb, *Vb, *Ub, *SZ, *Y;
};
__device__ __forceinline__ float wave_sum(float v) {
#pragma unroll
    for (int o = 1; o < 64; o <<= 1) v += __shfl_xor(v, o);
    return v;
}
__device__ __forceinline__ float wave_max(float v) {
#pragma unroll
    for (int o = 1; o < 64; o <<= 1) v = fmaxf(v, __shfl_xor(v, o));
    return v;
}
__device__ __forceinline__ void p0_mod_item(Frame& F, int item) {
    const int cg = item % 48, kq = item / 48, n = cg * 64 + F.lane, k0 = kq * 256 + F.wave * 32;
    float wv[32];
#pragma unroll
    for (int i = 0; i < 32; ++i) wv[i] = __builtin_nontemporal_load(F.w_ada + (size_t)(k0 + i) * 3072 + n);
    float a0 = 0.f, a1 = 0.f, a2 = 0.f, a3 = 0.f;
#pragma unroll
    for (int i = 0; i < 32; ++i) { a0 += F.c[k0 + i] * wv[i]; a1 += F.c[1024 + k0 + i] * wv[i]; a2 += F.c[2048 + k0 + i] * wv[i]; a3 += F.c[3072 + k0 + i] * wv[i]; }
    LAS float* red = (LAS float*)F.lds;
    red[(F.wave * 4 + 0) * 64 + F.lane] = a0; red[(F.wave * 4 + 1) * 64 + F.lane] = a1; red[(F.wave * 4 + 2) * 64 + F.lane] = a2; red[(F.wave * 4 + 3) * 64 + F.lane] = a3;
    __syncthreads();
    if (F.tid < 256) { const int b = F.tid >> 6, col = F.tid & 63; float s = 0.f;
#pragma unroll
        for (int w = 0; w < 8; ++w) s += red[(w * 4 + b) * 64 + col];
        F.modp[(kq * 4 + b) * 3072 + cg * 64 + col] = s; }
    __syncthreads();
}
__device__ __forceinline__ void p0_transpose_item(const float* W, int K, int N, bf16* WT, LAS float* scr, int kb, int nb, int lane) {
    const int k0 = 64 * kb, n0 = 32 * nb;
#pragma unroll 8
    for (int i = 0; i < 32; ++i) { const int kk = 2 * i + (lane >> 5); scr[kk * 33 + (lane & 31)] = __builtin_nontemporal_load(W + (size_t)(k0 + kk) * N + n0 + (lane & 31)); }
    LDS_WAIT(); asm volatile("" ::: "memory");
    const int c = lane & 7;
#pragma unroll
    for (int j = 0; j < 4; ++j) { const int n = (lane >> 3) + 8 * j; const LAS float* s = scr + (8 * c) * 33 + n;
        v4u o; o.x = pk2(s[0 * 33], s[1 * 33]); o.y = pk2(s[2 * 33], s[3 * 33]); o.z = pk2(s[4 * 33], s[5 * 33]); o.w = pk2(s[6 * 33], s[7 * 33]);
        *(GAS v4u*)(WT + (size_t)(n0 + n) * K + k0 + 8 * c) = o; }
    LDS_WAIT(); asm volatile("" ::: "memory");
}
__device__ __forceinline__ void p0_fold_item(Frame& F, int item) {
    const int g = item >> 8, k0 = (item & 255) * 4, lane = F.lane;
    const float* wp = F.w_pool + (size_t)g * 128 * 128;
    const float* wi = F.w_in + (size_t)k0 * 3072 + 1536 + g * 128;
    float acc0[4], acc1[4];
#pragma unroll
    for (int kk = 0; kk < 4; ++kk) { acc0[kk] = 0.f; acc1[kk] = 0.f; }
#pragma unroll 8
    for (int i = 0; i < 128; ++i) {
        const float w0 = wp[i * 128 + lane], w1 = wp[i * 128 + 64 + lane];
#pragma unroll
        for (int kk = 0; kk < 4; ++kk) { const float a = wi[(size_t)kk * 3072 + i]; acc0[kk] += a * w0; acc1[kk] += a * w1; }
    }
    const float s0 = F.pool_scale[g * 128 + lane], s1 = F.pool_scale[g * 128 + 64 + lane];
    typedef unsigned v2u __attribute__((ext_vector_type(2)));
    v2u o; o.x = pk2(acc0[0] * s0, acc0[1] * s0); o.y = pk2(acc0[2] * s0, acc0[3] * s0);
    *(GAS v2u*)(F.Wt_in + (size_t)(1536 + g * 128 + lane) * 1024 + k0) = o;
    o.x = pk2(acc1[0] * s1, acc1[1] * s1); o.y = pk2(acc1[2] * s1, acc1[3] * s1);
    *(GAS v2u*)(F.Wt_in + (size_t)(1536 + g * 128 + 64 + lane) * 1024 + k0) = o;
}
__device__ __forceinline__ void p0_table_item(Frame& F, int h) {
    const int lane = F.lane;
    const float gq = wave_max(fabsf(F.qg[lane])), gk = wave_max(fabsf(F.kg[lane]));
    float bm = -1e30f;
    for (int i = lane; i < 513; i += 64) bm = fmaxf(bm, F.rel_bias[h * 513 + i]);
    bm = wave_max(bm);
    const float M2 = (8.0f * gq * gk * 1.02f + bm) * LOG2E;
    float* T = F.tbg + h * att::TBG_STRIDE;
    for (int idx = lane; idx < att::TB_FLOATS; idx += 64) { const int s = idx / att::TB_COPY, i = idx % att::TB_COPY; int rel = i + s - att::TB_ORG; rel = rel < -256 ? -256 : (rel > 256 ? 256 : rel);
        T[idx] = F.rel_bias[h * 513 + rel + 256] * LOG2E - M2; }
    if (lane == 0) T[att::TB_FLOATS] = F.rel_bias[h * 513] * LOG2E - M2;
}
__device__ __forceinline__ void p0_prologue(Frame& F) {
    for (int item = F.vcu; item < 192; item += F.G) p0_mod_item(F, item);
}
__device__ __forceinline__ void p0_weights(Frame& F, int gw, int NGW) {
    LAS float* scr = (LAS float*)(F.lds + F.wave * 16384);
    constexpr int I_TIN = 16 * 80, I_TOUT = 16 * 32, I_FOLD = 1024, NITEMS = I_TIN + I_TOUT + I_FOLD + 8;
    for (int rnd = 0; rnd * NGW < NITEMS; ++rnd) {
        const int it = rnd * NGW + ((rnd & 1) ? gw : NGW - 1 - gw); if (it >= NITEMS) continue;
        if (it < I_FOLD) { p0_fold_item(F, it); continue; }
        if (it < I_FOLD + 8) { p0_table_item(F, it - I_FOLD); continue; }
        const int t = it - I_FOLD - 8;
        if (t < I_TIN) { const int kb = t / 80, nbp = t % 80, nb = nbp < 48 ? nbp : nbp + 16; p0_transpose_item(F.w_in, 1024, 3072, F.Wt_in, scr, kb, nb, F.lane); }
        else { const int r = t - I_TIN; p0_transpose_item(F.w_out, 1024, 1024, F.Wt_out, scr, r / 32, r % 32, F.lane); }
    }
}
__device__ __forceinline__ float mod_at(const Frame& F, int b, int col) {
    return ((F.modp[(0 * 4 + b) * 3072 + col] + F.modp[(1 * 4 + b) * 3072 + col]) + (F.modp[(2 * 4 + b) * 3072 + col] + F.modp[(3 * 4 + b) * 3072 + col])) + F.b_ada[col];
}
__device__ __forceinline__ f32x4 mod_at4(const Frame& F, int b, int col) {
    const f32x4 p0 = *(const f32x4*)(F.modp + (0 * 4 + b) * 3072 + col), p1 = *(const f32x4*)(F.modp + (1 * 4 + b) * 3072 + col), p2 = *(const f32x4*)(F.modp + (2 * 4 + b) * 3072 + col), p3 = *(const f32x4*)(F.modp + (3 * 4 + b) * 3072 + col);
    return ((p0 + p1) + (p2 + p3)) + *(const f32x4*)(F.b_ada + col);
}
__device__ __forceinline__ void p1_xn(Frame& F, int gw, int NGW, int b0, int nb) {
    for (int i = gw * 64 + F.lane; i < nb * 3072; i += NGW * 64) F.modf[b0 * 3072 + i] = mod_at(F, b0 + i / 3072, i % 3072);
    const int rows = nb * SEQ, rpw = (((rows + NGW - 1) / NGW) + 3) & ~3;
    const int m0 = b0 * SEQ + gw * rpw, m1 = (m0 + rpw < (b0 + nb) * SEQ) ? m0 + rpw : (b0 + nb) * SEQ;
    f32x4 gs[4], sh[4]; int curb = -1;
    for (int m = m0; m < m1; m += 4) {
        const int b = m / SEQ;
        if (b != curb) { curb = b;
#pragma unroll
            for (int j = 0; j < 4; ++j) { const int col = 4 * F.lane + 256 * j;
                const f32x4 g4 = *(const f32x4*)(F.norm_g + col), sc4 = mod_at4(F, b, 1024 + col);
                sh[j] = mod_at4(F, b, col); gs[j] = g4 * (sc4 + 1.0f); } }
        f32x4 v[4][4]; float s2[4];
#pragma unroll
        for (int r = 0; r < 4; ++r) { const GAS f32x4* xr = (const GAS f32x4*)(F.x + (size_t)(m + r) * DMODEL) + F.lane;
#pragma unroll
            for (int j = 0; j < 4; ++j) v[r][j] = __builtin_nontemporal_load(xr + 64 * j); }
#pragma unroll
        for (int r = 0; r < 4; ++r) { s2[r] = 0.f;
#pragma unroll
            for (int j = 0; j < 4; ++j) s2[r] += (v[r][j].x * v[r][j].x + v[r][j].y * v[r][j].y) + (v[r][j].z * v[r][j].z + v[r][j].w * v[r][j].w); }
#pragma unroll
        for (int o = 1; o < 64; o <<= 1) {
#pragma unroll
            for (int r = 0; r < 4; ++r) s2[r] += __shfl_xor(s2[r], o); }
#pragma unroll
        for (int r = 0; r < 4; ++r) { const float rstd = 1.0f / sqrtf(s2[r] * (1.0f / DMODEL) + RMS_EPS);
            GAS unsigned long long* o8 = (GAS unsigned long long*)(F.XN + (size_t)(m + r) * DMODEL) + F.lane;
#pragma unroll
            for (int j = 0; j < 4; ++j) { const f32x4 y = v[r][j] * rstd * gs[j] + sh[j];
                o8[64 * j] = (unsigned long long)pk2(y.x, y.y) | ((unsigned long long)pk2(y.z, y.w) << 32); } }
    }
}

struct Args { const float* in[12]; float* out; unsigned char* ws; int ph_lo, ph_hi, li, pad; };
__global__ void __launch_bounds__(NWAVES * 64, 2) mk_fwd(Args args) {
    extern __shared__ __attribute__((aligned(16))) unsigned char lds[];
    Frame F;
    F.lds = (LAS unsigned char*)lds;
    F.MISC = (volatile LAS unsigned*)(F.lds + LDSCTL_OFF);
    F.tid = threadIdx.x; F.lane = F.tid & 63; F.wave = __builtin_amdgcn_readfirstlane(F.tid >> 6);
    F.G = gridDim.x; { const int bx = blockIdx.x; F.vcu = (F.G % 8 == 0) ? (bx % 8) * (F.G / 8) + bx / 8 : bx; }
    unsigned char* ws = args.ws;
    F.ctl = (gu32*)(ws + WS_CTL);
    F.x = args.in[0]; F.c = args.in[1]; F.norm_g = args.in[2]; F.w_ada = args.in[3]; F.b_ada = args.in[4]; F.w_in = args.in[5];
    F.qg = args.in[6]; F.kg = args.in[7]; F.rel_bias = args.in[8]; F.w_pool = args.in[9]; F.pool_scale = args.in[10]; F.w_out = args.in[11]; F.out = args.out;
    F.modf = (float*)(ws + WS_MOD); F.modp = (float*)(ws + WS_MODP); F.tbg = (float*)(ws + WS_TBG);
    F.Wt_in = (bf16*)(ws + WS_WIN); F.Wt_out = (bf16*)(ws + WS_WOUT); F.XN = (bf16*)(ws + WS_XN);
    F.Qb = (bf16*)(ws + WS_Q); F.Kb = (bf16*)(ws + WS_K); F.Vb = (bf16*)(ws + WS_V); F.Ub = (bf16*)(ws + WS_U); F.SZ = (bf16*)(ws + WS_SZ); F.Y = (bf16*)(ws + WS_Y);
    for (int u = F.tid; u < (LDS_BYTES - LDSCTL_OFF) / 4; u += NWAVES * 64) ((LAS unsigned*)(F.lds + LDSCTL_OFF))[u] = 0u;
    __syncthreads();
    XcdBarrier bar; bar.bar = (unsigned*)(F.ctl + CW_BAR); bar.x = 0; bar.st = nullptr; bar.expect = 0;
    if (N_LAUNCHES != PER_PHASE) bar = xcd_barrier_post((unsigned*)(F.ctl + CW_BAR), F.MISC + 8, (unsigned)F.G);
#define GRID_BAR() do { if (N_LAUNCHES != PER_PHASE) { for (int rb_ = 0; rb_ < REP_BAR; ++rb_) xcd_barrier(bar); } } while (0)
#if PROBE_STAMP >= 0
#define STAMP(j) do { if (blockIdx.x == 0 && F.tid == 0) { const unsigned long long t_ = __builtin_amdgcn_s_memrealtime(); F.MISC[16 + 2 * (j)] = (unsigned)t_; F.MISC[17 + 2 * (j)] = (unsigned)(t_ >> 32); } } while (0)
#else
#define STAMP(j) do {} while (0)
#endif
    STAMP(0);
#if QUARTERS
    if (N_LAUNCHES == 1 && (F.G % 32) == 0) {
        const int Gq = F.G / 4, bx = blockIdx.x, q = (bx & 7) >> 1, lc = (bx & 1) * (Gq / 2) + (bx >> 3);
        const int gwl = lc * NWAVES + F.wave, ngwl = Gq * NWAVES;
        XcdBarrier qbar = xcd_barrier_post((unsigned*)(F.ctl + CW_BAR) + (1 + q) * XCD_BAR_WORDS, F.MISC + 10, (unsigned)Gq);
        p0_prologue(F);
        xcd_barrier(bar);
        if (q == 0) p1_xn(F, gwl, ngwl, 0, 1);
        else p0_weights(F, ((q - 1) * Gq + lc) * NWAVES + F.wave, 3 * Gq * NWAVES);
        xcd_barrier(bar);
        if (q >= 2) { const unsigned long long t0_ = __builtin_amdgcn_s_memrealtime(), want_ = (unsigned long long)(q - 1) * STAG_TICKS; while (__builtin_amdgcn_s_memrealtime() - t0_ < want_) __builtin_amdgcn_s_sleep(16); }
        if (q > 0) p1_xn(F, gwl, ngwl, q, 1);
        xcd_barrier(qbar);
        const size_t rowoff = (size_t)q * SEQ;
        {
            pg8::Gemm g{F.XN + rowoff * DMODEL, F.Wt_in, SEQ, NPROJ, DMODEL}; pg8::HalvesOrder S; S.init(SEQ, NPROJ, Gq, lc);
            pg8::EpiProj E{F.Qb + rowoff * 512, F.Kb + rowoff * 512, F.Vb + rowoff * 512, F.Ub + rowoff * 512, F.SZ + rowoff * 1024, F.qg, F.kg, QSCALE, F.lds + pg8::STAGE_BYTES};
            pg8::gemm_phase<pg8::EpiProj, pg8::HalvesOrder, PG8_ALIGN, PG8_SP2>(F.lds, g, S, E);
        }
        xcd_barrier(qbar);
        {
            const att::Tensors AT{(const att::bf16*)F.Qb, (const att::bf16*)F.Kb, (const att::bf16*)F.Vb, (const att::bf16*)F.Ub, (const att::bf16*)F.SZ, (att::bf16*)F.Y, F.tbg};
            const int nuq = att::NUNITS / 4, upc = (nuq + Gq - 1) / Gq;
            const int i0 = q * nuq + lc * upc, i1 = (lc * upc + upc < nuq) ? i0 + upc : q * nuq + nuq;
            int idx = i0;
            while (idx < i1) {
                if ((idx & 31) < 2) { att::attn_unit(idx >> 8, (idx >> 5) & 7, idx & 31, AT, (char*)lds); ++idx; continue; }
                int e = idx + 1; while (e < i1 && (e & 31) != 0) ++e;
                att::attn_run_p<0>(idx >> 8, (idx >> 5) & 7, idx & 31, e - idx, AT, (char*)lds); idx = e;
            }
            const int npq = att::NPOOL_ITEMS / 4;
            for (int it = gwl; it < npq; it += ngwl) att::pool_dispatch(q * npq + it, AT, F.lane);
        }
        xcd_barrier(qbar);
        {
            pg8::Gemm g{F.Y + rowoff * DMODEL, F.Wt_out, SEQ, DMODEL, DMODEL}; pg8::HalvesOrder S; S.init(SEQ, DMODEL, Gq, lc);
            pg8::EpiOut E{F.x + rowoff * DMODEL, F.out + rowoff * DMODEL, F.modf + q * 3072, 1 << 30, F.lds + pg8::STAGE_BYTES};
            pg8::gemm_phase<pg8::EpiOut, pg8::HalvesOrder, PG8_ALIGN, PG8_SP2>(F.lds, g, S, E);
        }
        return;
    }
#endif
#if !QUARTERS
    const int lo = args.ph_lo, hi = args.ph_hi;
#define IN(k) (lo <= (k) && (k) < hi)
#define BOTH(k) (IN(k) && IN((k) + 1))
    if (IN(0)) { for (int rep = 0; rep < REP_P0; ++rep) p0_prologue(F); if (BOTH(0)) GRID_BAR(); STAMP(1); }
    if (IN(1)) { const int gwa = F.vcu * NWAVES + F.wave, ngwa = F.G * NWAVES; if (F.wave & 1) p0_weights(F, gwa, ngwa); for (int rep = 0; rep < REP_P1; ++rep) p1_xn(F, gwa, ngwa, 0, BATCH); if (!(F.wave & 1)) p0_weights(F, gwa, ngwa);
 if (BOTH(1)) GRID_BAR(); STAMP(2); }
    if (IN(2)) {
        pg8::Gemm g{F.XN, F.Wt_in, MROWS, NPROJ, DMODEL}; pg8::StaticOrder S; S.init(MROWS, NPROJ, F.G, (int)blockIdx.x, REP_P2);
        pg8::EpiProj E{F.Qb, F.Kb, F.Vb, F.Ub, F.SZ, F.qg, F.kg, QSCALE, F.lds + pg8::STAGE_BYTES};
        pg8::gemm_phase<pg8::EpiProj, pg8::StaticOrder, PG8_ALIGN, PG8_SP2>(F.lds, g, S, E);
#if PROBE_P2B
        GRID_BAR();
        pg8::gemm_phase<pg8::EpiProj, pg8::StaticOrder, PG8_ALIGN, PG8_SP2>(F.lds, g, S, E);
#endif
        if (BOTH(2)) GRID_BAR();
        STAMP(3);
    }
    if (IN(3)) {
        const att::Tensors AT{(const att::bf16*)F.Qb, (const att::bf16*)F.Kb, (const att::bf16*)F.Vb, (const att::bf16*)F.Ub, (const att::bf16*)F.SZ, (att::bf16*)F.Y, F.tbg};
        const int upc = (att::NUNITS + F.G - 1) / F.G;
#if SHADOW_VAR >= 0
        const att::Tensors ATS{AT.Q, AT.K, AT.V, AT.U, AT.SZ, (att::bf16*)(args.ws + WS_END), AT.tbg};
#endif
#if POOL_FIRST
#define POOL_ITEMS() do { const int gw = F.vcu * NWAVES + F.wave, NGW = F.G * NWAVES; \
          for (int it = gw; it < att::NPOOL_ITEMS * REP_P3B; it += NGW) att::pool_dispatch(it % att::NPOOL_ITEMS, AT, F.lane); } while (0)
        const bool pool_first = (POOL_FIRST == 2) ? true : ((blockIdx.x >> 3) & 1) != 0;
        if (pool_first) POOL_ITEMS();
#endif
#if !(DBG_NAIVE & 32)
        for (int rep_ = 0; rep_ < REP_P3A; ++rep_) {
            const int i0 = F.vcu * upc, i1 = (i0 + upc < att::NUNITS) ? i0 + upc : att::NUNITS;
            int idx = i0;
            while (idx < i1) {
                if ((idx & 31) < 2) { att::attn_unit(idx >> 8, (idx >> 5) & 7, idx & 31, AT, (char*)lds); ++idx; continue; }
                int e = idx + 1; while (e < i1 && (e & 31) != 0) ++e;
                if (rep_ == 0) att::attn_run_p<0>(idx >> 8, (idx >> 5) & 7, idx & 31, e - idx, AT, (char*)lds);
#if SHADOW_VAR >= 0
                else att::attn_run_p<SHADOW_VAR>(idx >> 8, (idx >> 5) & 7, idx & 31, e - idx, ATS, (char*)lds);
#endif
                idx = e;
            }
        }
#endif
#if POOL_FIRST
        if (!pool_first) POOL_ITEMS();
#elif !(DBG_NAIVE & 64)
        { const int gw = F.vcu * NWAVES + F.wave, NGW = F.G * NWAVES;
          for (int it = gw; it < att::NPOOL_ITEMS * REP_P3B; it += NGW) att::pool_dispatch(it % att::NPOOL_ITEMS, AT, F.lane); }
#endif
        if (BOTH(3)) GRID_BAR();
        STAMP(4);
    }
    if (IN(4)) {
        pg8::Gemm g{F.Y, F.Wt_out, MROWS, DMODEL, DMODEL}; pg8::StaticOrder S; S.init(MROWS, DMODEL, F.G, (int)blockIdx.x, REP_P4, WGM_P4);
        pg8::EpiOut E{F.x, F.out, F.modf, SEQ, F.lds + pg8::STAGE_BYTES};
#if P4_STAGGER_TICKS > 0
        if (blockIdx.x & 8) { const unsigned long long t0_ = __builtin_amdgcn_s_memrealtime(); while (__builtin_amdgcn_s_memrealtime() - t0_ < P4_STAGGER_TICKS) __builtin_amdgcn_s_sleep(16); }
#endif
        pg8::gemm_phase<pg8::EpiOut, pg8::StaticOrder, P4_ALIGN, PG8_SP2>(F.lds, g, S, E);
    }
#if PROBE_STAMP >= 0
    GRID_BAR(); STAMP(5);
    if (blockIdx.x == 0 && F.tid == 0) {
        const unsigned long long ta = ((unsigned long long)F.MISC[17 + 2 * PROBE_STAMP] << 32) | F.MISC[16 + 2 * PROBE_STAMP], tb = ((unsigned long long)F.MISC[19 + 2 * PROBE_STAMP] << 32) | F.MISC[18 + 2 * PROBE_STAMP];
        const unsigned long long t5 = __builtin_amdgcn_s_memrealtime(), want = (tb - ta) * PROBE_AMP;
        while (__builtin_amdgcn_s_memrealtime() - t5 < want) __builtin_amdgcn_s_sleep(8);
    }
#endif
#undef IN
#undef BOTH
#endif
#undef GRID_BAR
}


#ifndef DBG_NAIVE
#define DBG_NAIVE 0
#endif
#if DBG_NAIVE
__device__ __forceinline__ float dbg_bf(bf16 v) { return __builtin_bit_cast(float, (unsigned)v << 16); }
__device__ __forceinline__ bf16 dbg_tobf(float f) { return (bf16)f2bf(f); }
__global__ void __launch_bounds__(256) dbg_gemm_bf16(const bf16* __restrict__ A, int lda, const bf16* __restrict__ Bt, int ldb, float* __restrict__ C, int ldc, int K) {
    __shared__ float As[16][64 + 4];
    __shared__ float Bs[16][64 + 4];
    const int tid = threadIdx.x, tx = tid & 15, ty = tid >> 4;
    const int m0 = blockIdx.y * 64, n0 = blockIdx.x * 64;
    float acc[4][4] = {};
    for (int k0 = 0; k0 < K; k0 += 16) {
        { const int r = tid >> 2, kk = (tid & 3) * 4;
#pragma unroll
          for (int j = 0; j < 4; ++j) { As[kk + j][r] = dbg_bf(A[(size_t)(m0 + r) * lda + k0 + kk + j]); Bs[kk + j][r] = dbg_bf(Bt[(size_t)(n0 + r) * ldb + k0 + kk + j]); } }
        __syncthreads();
#pragma unroll
        for (int kk = 0; kk < 16; ++kk) {
            const float4 a = *(const float4*)&As[kk][ty * 4]; const float4 b = *(const float4*)&Bs[kk][tx * 4];
            const float av[4] = {a.x, a.y, a.z, a.w}, bv[4] = {b.x, b.y, b.z, b.w};
#pragma unroll
            for (int i = 0; i < 4; ++i)
#pragma unroll
                for (int j = 0; j < 4; ++j) acc[i][j] += av[i] * bv[j];
        }
        __syncthreads();
    }
    for (int i = 0; i < 4; ++i) *(float4*)(C + (size_t)(m0 + ty * 4 + i) * ldc + n0 + tx * 4) = make_float4(acc[i][0], acc[i][1], acc[i][2], acc[i][3]);
}
__global__ void dbg_epi_slab(const float* __restrict__ Cs, int s, bf16* Qb, bf16* Kb, bf16* Vb, bf16* Ub, bf16* SZ, const float* qg, const float* kg) {
    const int idx = blockIdx.x * 256 + threadIdx.x; const int row = idx >> 3, hh = idx & 7;
    const float* p = Cs + (size_t)row * 512 + hh * 64;
    if (s < 2) { float ss = 0.f; for (int d = 0; d < 64; ++d) ss += p[d] * p[d];
        const float r = 1.0f / sqrtf(ss / 64.f + 1e-6f); const float* g = s == 0 ? qg : kg; const float sc = s == 0 ? QSCALE : 1.0f; bf16* o = (s == 0 ? Qb : Kb) + (size_t)row * 512 + hh * 64;
        for (int d = 0; d < 64; ++d) o[d] = dbg_tobf(p[d] * r * g[d] * sc); }
    else if (s < 4) { bf16* o = (s == 2 ? Vb : Ub) + (size_t)row * 512 + hh * 64; for (int d = 0; d < 64; ++d) o[d] = dbg_tobf(p[d]); }
    else { bf16* o = SZ + (size_t)row * 1024 + (s - 4) * 512 + hh * 64; for (int d = 0; d < 64; ++d) { const float z = p[d]; o[d] = dbg_tobf(z / (1.0f + __expf(-z))); } }
}
__global__ void __launch_bounds__(64) dbg_attn(const bf16* __restrict__ Qb, const bf16* __restrict__ Kb, const bf16* __restrict__ Vb, const bf16* __restrict__ SZ, bf16* __restrict__ Y, const float* __restrict__ rel_bias) {
    const int idx = blockIdx.x * 64 + threadIdx.x;
    const int i = idx % SEQ, bh = idx / SEQ, h = bh % NHEAD, b = bh / NHEAD;
    const size_t row = (size_t)b * SEQ + i;
    float q[64], o[64];
#pragma unroll
    for (int d = 0; d < 64; ++d) { q[d] = dbg_bf(Qb[row * 512 + h * 64 + d]); o[d] = 0.f; }
    const int n = i / 64; int j0 = (n - 8) * 64; if (j0 < 0) j0 = 0; const int j1 = n * 64 + 63;
    float mx = -1e30f, l = 0.f;
    for (int j = j0; j <= j1; ++j) {
        const bf16* kp = Kb + ((size_t)b * SEQ + j) * 512 + h * 64; const bf16* vp = Vb + ((size_t)b * SEQ + j) * 512 + h * 64;
        float sc = 0.f;
#pragma unroll
        for (int d = 0; d < 64; ++d) sc += q[d] * dbg_bf(kp[d]);
        int rel = j - i; rel = rel < -256 ? -256 : (rel > 256 ? 256 : rel);
        sc += rel_bias[h * 513 + rel + 256] * LOG2E;
        const float mn = fmaxf(mx, sc), f = exp2f(mx - mn), p = exp2f(sc - mn);
        l = l * f + p; mx = mn;
#pragma unroll
        for (int d = 0; d < 64; ++d) o[d] = o[d] * f + p * dbg_bf(vp[d]);
    }
    const float rl = 1.0f / l;
#pragma unroll
    for (int d = 0; d < 64; ++d) Y[row * 1024 + h * 64 + d] = dbg_tobf(o[d] * rl * dbg_bf(SZ[row * 1024 + h * 64 + d]));
}
__global__ void dbg_pool(const bf16* __restrict__ Ub, const bf16* __restrict__ SZ, bf16* __restrict__ Y) {
    const int idx = blockIdx.x * 256 + threadIdx.x; const int row = idx >> 9, ch = idx & 511, g = ch >> 7, w = 2 << g;
    const int t = row % SEQ; const int cnt = (t + 1 < w) ? t + 1 : w;
    float s = 0.f; for (int a = 0; a < cnt; ++a) s += dbg_bf(Ub[(size_t)(row - a) * 512 + ch]);
    Y[(size_t)row * 1024 + 512 + ch] = dbg_tobf((s / (float)cnt - dbg_bf(Ub[(size_t)row * 512 + ch])) * dbg_bf(SZ[(size_t)row * 1024 + 512 + ch]));
}
__global__ void dbg_out(float* __restrict__ out, const float* __restrict__ x, const float* __restrict__ modf) {
    const size_t idx = (size_t)blockIdx.x * 256 + threadIdx.x; const size_t row = idx >> 10; const int cidx = (int)(idx & 1023); const int b = (int)(row / SEQ);
    out[idx] = x[idx] + modf[b * 3072 + 2048 + cidx] * out[idx];
}
#endif

extern "C" void kernel_launch(void* const* d_in, const int* in_sizes, int n_in, void* d_out, int out_size, void* d_ws, size_t ws_size, hipStream_t stream) {
    static int grid = 0;
    if (grid == 0) {
        if (n_in != 12 || in_sizes[0] != MROWS * DMODEL || out_size != MROWS * DMODEL || ws_size < WS_END) { fprintf(stderr, "kernel_launch: unexpected shapes (n_in %d, in0 %d, out %d, ws %zu); nothing launched\n", n_in, n_in > 0 ? in_sizes[0] : -1, out_size, ws_size); grid = -1; return; }
        int dev = 0, cus = 0, per_cu = 0;
        if (hipGetDevice(&dev) != hipSuccess || hipDeviceGetAttribute(&cus, hipDeviceAttributeMultiprocessorCount, dev) != hipSuccess) { grid = -1; return; }
        if (hipFuncSetAttribute((const void*)mk_fwd, hipFuncAttributeMaxDynamicSharedMemorySize, LDS_BYTES) != hipSuccess) { fprintf(stderr, "kernel_launch: hipFuncSetAttribute failed\n"); grid = -1; return; }
        if (hipOccupancyMaxActiveBlocksPerMultiprocessor(&per_cu, (const void*)mk_fwd, NWAVES * 64, LDS_BYTES) != hipSuccess || per_cu < 1) { fprintf(stderr, "kernel_launch: occupancy query reports %d workgroups per CU\n", per_cu); per_cu = 0; }
        (void)hipGetLastError();
#if QUARTERS
        if (cus % 32 != 0) { fprintf(stderr, "kernel_launch: the staggered-groups build needs a CU count that is a multiple of 32 (got %d); nothing launched\n", cus); grid = -1; return; }
#endif
        grid = cus * (per_cu >= 1 ? 1 : 0);
        if (grid == 0) { grid = -1; return; }
    }
    if (grid < 0) return;
    for (int pass_ = 0; pass_ < REP_ALL; ++pass_) {
#if WS_AT_END
    unsigned char* const wsb = (unsigned char*)d_ws + ((ws_size - WS_END) & ~(size_t)(MiB - 1));
#else
    unsigned char* const wsb = (unsigned char*)d_ws;
#endif
    for (int ms_ = 0; ms_ < REP_MEMSET; ++ms_) (void)hipMemsetAsync((char*)wsb + WS_CTL, 0, CTL_ZERO_BYTES, stream);
    Args a{};
    for (int i = 0; i < 12; ++i) a.in[i] = (const float*)d_in[i];
    a.out = (float*)d_out; a.ws = wsb;
    for (int li = 0; li < N_LAUNCHES; ++li) {
        a.ph_lo = (N_LAUNCHES == PER_PHASE) ? li : 0; a.ph_hi = (N_LAUNCHES == PER_PHASE) ? li + 1 : PER_PHASE; a.li = li;
#if DBG_NAIVE
        if ((DBG_NAIVE >> li) & 1) {
            unsigned char* ws = (unsigned char*)d_ws; bf16 *XN = (bf16*)(ws + WS_XN), *Wt_in = (bf16*)(ws + WS_WIN), *Wt_out = (bf16*)(ws + WS_WOUT), *Qb = (bf16*)(ws + WS_Q), *Kb = (bf16*)(ws + WS_K), *Vb = (bf16*)(ws + WS_V), *Ub = (bf16*)(ws + WS_U), *SZ = (bf16*)(ws + WS_SZ), *Y = (bf16*)(ws + WS_Y);
            float* tmp = (float*)(ws + WS_END); float* modf = (float*)(ws + WS_MOD);
            if (li == 2) { for (int s = 0; s < 6; ++s) { dbg_gemm_bf16<<<dim3(512 / 64, MROWS / 64), 256, 0, stream>>>(XN, 1024, Wt_in + (size_t)s * 512 * 1024, 1024, tmp, 512, 1024);
                    dbg_epi_slab<<<MROWS * 8 / 256, 256, 0, stream>>>(tmp, s, Qb, Kb, Vb, Ub, SZ, a.in[6], a.in[7]); } continue; }
            if (li == 3) { dbg_attn<<<BATCH * NHEAD * SEQ / 64, 64, 0, stream>>>(Qb, Kb, Vb, SZ, Y, a.in[8]); dbg_pool<<<MROWS * 512 / 256, 256, 0, stream>>>(Ub, SZ, Y); continue; }
            if (li == 4) { dbg_gemm_bf16<<<dim3(1024 / 64, MROWS / 64), 256, 0, stream>>>(Y, 1024, Wt_out, 1024, (float*)d_out, 1024, 1024); dbg_out<<<MROWS * 1024 / 256, 256, 0, stream>>>((float*)d_out, a.in[0], modf); continue; }
        }
#endif
#if USE_COOP
        { void* kargs[] = {(void*)&a}; const hipError_t ce = hipLaunchCooperativeKernel((const void*)mk_fwd, dim3(grid), dim3(NWAVES * 64), kargs, LDS_BYTES, stream);
          if (ce != hipSuccess) fprintf(stderr, "kernel_launch: cooperative launch failed: %s (grid %d)\n", hipGetErrorString(ce), grid); }
#else
        hipLaunchKernelGGL(mk_fwd, dim3(grid), dim3(NWAVES * 64), LDS_BYTES, stream, a);
#endif
#if DBG_NAIVE & 96
        if (li == 3) { unsigned char* ws = (unsigned char*)d_ws; bf16 *Qb = (bf16*)(ws + WS_Q), *Kb = (bf16*)(ws + WS_K), *Vb = (bf16*)(ws + WS_V), *Ub = (bf16*)(ws + WS_U), *SZ = (bf16*)(ws + WS_SZ), *Y = (bf16*)(ws + WS_Y);
            if (DBG_NAIVE & 32) dbg_attn<<<BATCH * NHEAD * SEQ / 64, 64, 0, stream>>>(Qb, Kb, Vb, SZ, Y, a.in[8]);
            if (DBG_NAIVE & 64) dbg_pool<<<MROWS * 512 / 256, 256, 0, stream>>>(Ub, SZ, Y); }
#endif
    }
    }
}
```

```cpp
#include <hip/hip_runtime.h>
#include <hip/hip_bf16.h>
#include <cstdio>
#include <cstdint>
#include <cmath>

constexpr int BATCH = 4, SEQ = 8192, DMODEL = 1024, MROWS = BATCH * SEQ;
constexpr int NHEAD = 8, HDIM = 64, AW = 512, PWID = 512, NPROJ = 3072;
constexpr float RMS_EPS = 1e-6f;
constexpr float LOG2E = 1.4426950408889634f;
constexpr float QSCALE = 0.125f * LOG2E;
#define DBG_NAIVE 0
#define MK_N_LAUNCHES 1
#define PROBE_P2B 0
#define P4_ALIGN true
#define POOL_FIRST 0
#define FAST_RCP 1
#define FAST_RCP_POOL 0
#define TRANS_FULL 0
#define TM_Q 1
#define P12_OVERLAP 0
#define NORM_PERMLANE 1
#define SILU_PK 1
#define BAR_L2 0
#define X_TOUCH 0
#define POOL_SPLIT 0
#define FAR_CONST 0
#define ATT_DMA_EARLY 0
#define P1_RPI 4
#define XB_RESID 0
#define SZ_PLAIN 0
#define P1_DYN 0
#define DIRECT_EPI2 0
#define GEMM_OPAQUE_TID 0
#define P1_ROT 0
#define P1_SHADOW_NOSTORE 0
#define P1_WFIRST 0
#define WEIGHT_BALANCE 0
#define P1_HWCVT 1
#define L8_XN (64ull << 20)
#define L8_Q ((192ull << 20) + 0ull)
#define L8_SZ (256ull << 20)
#define L8_PAD 0ull
#define L8_SZB 0ull
#define WGM_P2 4
#define P1_PIPE 0
#define P1_INTERLEAVE 1
#define FOLD_BLOCK 0
#define FOLD_V2 0
#define FOLD_REP 1
#define TRANS_REP 1
#define WEIGHTS_IN_P0 0
#define LAYOUT 4
#define XN_PLACE 0
#define XN_SHIFT 0
#define QKVU_IN_OUT 0
#define POOL_N1_AT 4
#define POOL_Z1_AT 8
#define P2_STAGGER_TICKS 0
#define P1_PRE 0
#define ATT_DMA_POL ""
#define P1_PLAIN_LOADS 0
#define PRETOUCH 0
#define POOL64 1
#define POOL_REUSE 1
#define NOFENCE 0
#define SPLIT34 0
#define LOCAL_P34 1
#define SLAB_ATT 1
#define EARLY_A11 0
#define EPI4_ROLL 0
#define X_PF_LOOP 0
#define Y_ALIAS 0
#define NT_PROJ 0
#define ATT_PRIO 0
#define GEMM_ORDER pg8::StaticOrder
#define WS_AT_END 0
#define WGM_P4 4
#define WT_STORES 0
#define QUARTERS 0
#define STAG_TICKS 1400
#define SHADOW_NODMA 0
#define USE_COOP 1
#define SHADOW_EPI4 0
#define SHADOW_EPI2 0
#define SHADOW_VAR -1
#define X_PREFETCH 0
#define X_PREFETCH_AT 3
#define P4_STAGGER_TICKS 0
#define PROBE_STAMP -1
#define PROBE_AMP 4
#define PROBE_BLK 0
#define PROBE_STAMP_B (PROBE_STAMP + 1)
#define REP_P0 1
#define REP_P1 1
#define REP_P2 1
#define REP_P3A 1
#define REP_P3B 1
#define REP_P4 1
#define REP_BAR 1
#define REP_ALL 1
#define REP_MEMSET 1
#define REP_EPI4 1
namespace pg8 {
#define PG8_LAS __attribute__((address_space(3)))
typedef unsigned short bf16_t;
typedef short bf16x8 __attribute__((ext_vector_type(8)));
typedef float f32x4 __attribute__((ext_vector_type(4)));
typedef unsigned u32x4 __attribute__((ext_vector_type(4)));
constexpr int BM = 256, BK = 64, HALF = 128, HTB = HALF * BK * 2  , STAGE_BYTES = 8 * HTB, NXCD = 8, WGM = 4;

__host__ __device__ __forceinline__ int lds_byte(int r, int c) { const int st = (r >> 4) * 2 + (c >> 5), rr = r & 15, cc = c & 31, ob = rr * 64 + cc * 2; return st * 1024 + (ob ^ (((ob >> 9) & 1) << 5)); }
__host__ __device__ __forceinline__ void stage_rc(int b, int& R, int& C) { const int st = b / 1024, sb = b % 1024, swz = sb ^ (((sb >> 9) & 1) << 5); R = (st >> 1) * 16 + swz / 64; C = (st & 1) * 32 + (swz % 64) / 2; }
__host__ __device__ __forceinline__ int perm32(int rho) { const int n = rho >> 4, i = rho & 15; return 8 * (i >> 2) + 4 * n + (i & 3); }

struct Unit { int pm, pn, sh; };
struct Gemm { const bf16_t* A; const bf16_t* Bt; int M, N, K; };

struct StaticOrder {
    static constexpr bool MIDK = (POOL_SPLIT != 0);
    int nM, nN, nwg, G, c, rep, wgm;
    unsigned* cnt = nullptr;
    __device__ __forceinline__ unsigned mid_peek(const Unit& u) const {
        return cnt == nullptr ? 16u : __hip_atomic_load(cnt + 64 * u.pm, __ATOMIC_RELAXED, __HIP_MEMORY_SCOPE_AGENT);
    }
    __device__ __forceinline__ void mid_ready(const Unit& u, unsigned peek) const {
        if (cnt == nullptr || peek >= 16u) return;
        unsigned* p = cnt + 64 * u.pm; unsigned sp = 0u;
        while (__hip_atomic_load(p, __ATOMIC_RELAXED, __HIP_MEMORY_SCOPE_AGENT) < 16u) { __builtin_amdgcn_s_sleep(2); if (++sp > (1u << 20)) break; }
    }
    __host__ __device__ void init(int M, int N, int G_, int c_, int rep_ = 1, int wgm_ = WGM) { nM = M / BM; nN = N / BM; nwg = nM * nN; G = G_; c = c_; rep = rep_; wgm = wgm_; }
    int sp_mode = 0, sp_x = 0, sp_cls = 0, sp_je = 0; unsigned* tcnt = nullptr; unsigned* wcnt = nullptr; unsigned wneed = 0u;
    __host__ __device__ bool next(int i, Unit& u) const {
        if (sp_mode) { const int q = i * 16 + sp_je; u.pm = 16 * sp_x + 8 * sp_cls + q / 12; u.pn = q % 12; u.sh = 0; return i < 6; }
        const int per = (nwg - c + G - 1) / G;
        if (per <= 0 || i >= per * rep) return false;
        const long L = (long)(i % per) * G + c; if (L >= nwg) return false; u.sh = (i >= per);
        int wgid = (int)L; { const int q = nwg / NXCD, r = nwg % NXCD, xcd = wgid % NXCD, off = wgid / NXCD; wgid = (xcd < r ? xcd * (q + 1) : r * (q + 1) + (xcd - r) * q) + off; }
        const int nig = wgm * nN, gid = wgid / nig, fm = gid * wgm, gsz = (nM - fm) < wgm ? (nM - fm) : wgm;
        u.pm = fm + ((wgid % nig) % gsz); u.pn = (wgid % nig) / gsz; return true;
    }
    __device__ __forceinline__ void a_ready(const Unit& u) const {
        if (tcnt == nullptr) return;
        unsigned sp = 0u;
        while (__hip_atomic_load(wcnt, __ATOMIC_RELAXED, __HIP_MEMORY_SCOPE_AGENT) < wneed) { __builtin_amdgcn_s_sleep(4); if (++sp > (1u << 20)) break; }
        while (__hip_atomic_load(tcnt + 64 * u.pm, __ATOMIC_RELAXED, __HIP_MEMORY_SCOPE_AGENT) < 64u) { __builtin_amdgcn_s_sleep(4); if (++sp > (1u << 20)) break; }
    }
    __device__ __forceinline__ void done(const Unit&) const {}
};

struct StageOrder {
    static constexpr bool MIDK = false; __device__ __forceinline__ unsigned mid_peek(const Unit&) const { return 16u; } __device__ __forceinline__ void mid_ready(const Unit&, unsigned) const {}
    StaticOrder S; int split, st, x, j;
    __host__ __device__ bool next(int i, Unit& u) const {
        Unit t; t.pm = 0; t.pn = 0; t.sh = 0; const bool ok = S.next(i, t);
        const int Rp = j >> 2, R = (Rp >> 1) * 4 + 2 * st + (Rp & 1);
        u.pm = split ? 16 * x + R : t.pm; u.pn = split ? (j & 3) : t.pn; u.sh = 0;
        return split ? (i == 0) : ok;
    }
    __device__ __forceinline__ void a_ready(const Unit&) const {}
    __device__ __forceinline__ void done(const Unit&) const {}
};

struct HalvesOrder {
    static constexpr bool MIDK = false; __device__ __forceinline__ unsigned mid_peek(const Unit&) const { return 16u; } __device__ __forceinline__ void mid_ready(const Unit&, unsigned) const {}
    int nM, nN, half, xh, cx;
    __host__ __device__ void init(int M, int N, int G, int c) { nM = M / BM; nN = N / BM; half = G / 2; xh = c / half; cx = c % half; }
    __host__ __device__ bool next(int i, Unit& u) const {
        const int mh = nM / 2, t = i * half + cx; if (t >= mh * nN) return false;
        const int nig = WGM * nN, g = t / nig, r = t % nig;
        u.pm = xh * mh + g * WGM + (r % WGM); u.pn = r / WGM; u.sh = 0; return true;
    }
    __device__ __forceinline__ void a_ready(const Unit&) const {}
    __device__ __forceinline__ void done(const Unit&) const {}
};

struct BlockOrder {
    static constexpr bool MIDK = false; __device__ __forceinline__ unsigned mid_peek(const Unit&) const { return 16u; } __device__ __forceinline__ void mid_ready(const Unit&, unsigned) const {}
    int nM, nN, x, cx, rep;
    __host__ __device__ void init(int M, int N, int G, int c, int rep_ = 1) { nM = M / BM; nN = N / BM; x = c % 8; cx = c / 8; rep = rep_; (void)G; }
    __host__ __device__ bool next(int i, Unit& u) const {
        const int nb = nN / 4, mper = nM / 8, per = (mper / 8) * nb; if (i >= per * rep) return false;
        const int ii = i % per, mg = ii / nb, cb = ii % nb;
        u.pm = x * mper + 8 * mg + (cx & 7); u.pn = 4 * cb + (cx >> 3); u.sh = (i >= per); return true;
    }
    __device__ __forceinline__ void a_ready(const Unit&) const {}
    __device__ __forceinline__ void done(const Unit&) const {}
};
__device__ __forceinline__ unsigned cvt_pk_bf16(float lo, float hi) { unsigned r; asm volatile("v_cvt_pk_bf16_f32 %0, %1, %2" : "=v"(r) : "v"(lo), "v"(hi)); return r; }
__device__ __forceinline__ float silu_f(float v) { return v * __builtin_amdgcn_rcpf(1.0f + __builtin_amdgcn_exp2f(-1.4426950408889634f * v)); }
__device__ __forceinline__ f32x4 silu4(f32x4 v) {
    const f32x4 t = v * -1.4426950408889634f;
    f32x4 e; e[0] = __builtin_amdgcn_exp2f(t[0]); e[1] = __builtin_amdgcn_exp2f(t[1]); e[2] = __builtin_amdgcn_exp2f(t[2]); e[3] = __builtin_amdgcn_exp2f(t[3]);
    e = e + 1.0f;
    f32x4 r; r[0] = __builtin_amdgcn_rcpf(e[0]); r[1] = __builtin_amdgcn_rcpf(e[1]); r[2] = __builtin_amdgcn_rcpf(e[2]); r[3] = __builtin_amdgcn_rcpf(e[3]);
    return v * r;
}
struct EpiProj {
    static constexpr bool PERM = true, AFTER_DRAIN = false, HEADPERM = true, XPF = false; static constexpr int NST = 16;
    bf16_t *Q, *Kb, *V, *U, *SZ; const float *qg, *kg; float qscale; PG8_LAS unsigned char* xl;
    template <int MODE> __device__ __forceinline__ void run(const f32x4 (&acc)[2][2][4][2], bf16_t* base, int ldc, int colw, int rowt, const float* g, float sc, int fr, int fq, PG8_LAS unsigned char* patch, bool wt = false) const {
        const int lane = fq * 16 + fr, rr = lane >> 3, cc = lane & 7;
        PG8_LAS unsigned char* wp = patch + fr * 144 + fq * 16;
        const PG8_LAS unsigned char* rp = patch + rr * 144 + cc * 16;
        f32x4 gv[2][2];
        if (MODE == 0) {
#pragma unroll
            for (int bj = 0; bj < 2; ++bj)
#pragma unroll
                for (int n = 0; n < 2; ++n) gv[bj][n] = *(const f32x4*)(g + 32 * bj + 8 * fq + 4 * n) * sc;
        }
#pragma unroll
        for (int ai = 0; ai < 2; ++ai)
#pragma unroll
            for (int m = 0; m < 4; ++m) {
                float rs = 1.f;
                if (MODE == 0) {
                    float ss = 0.f;
#pragma unroll
                    for (int bj = 0; bj < 2; ++bj)
#pragma unroll
                        for (int n = 0; n < 2; ++n) { const f32x4 x = acc[ai][bj][m][n]; ss += (x[0] * x[0] + x[1] * x[1]) + (x[2] * x[2] + x[3] * x[3]); }
#if NORM_PERMLANE
                    { auto r16 = __builtin_amdgcn_permlane16_swap(__float_as_uint(ss), __float_as_uint(ss), false, false); ss = __uint_as_float(r16[0]) + __uint_as_float(r16[1]);
                      auto r32 = __builtin_amdgcn_permlane32_swap(__float_as_uint(ss), __float_as_uint(ss), false, false); ss = __uint_as_float(r32[0]) + __uint_as_float(r32[1]); }
#else
                    ss += __shfl_xor(ss, 16); ss += __shfl_xor(ss, 32);
#endif
                    rs = FAST_RCP ? __builtin_amdgcn_rsqf(ss * (1.0f / 64.0f) + 1e-6f) : 1.0f / sqrtf(ss * (1.0f / 64.0f) + 1e-6f);
                }
#pragma unroll
                for (int bj = 0; bj < 2; ++bj) {
                    f32x4 v0 = acc[ai][bj][m][0], v1 = acc[ai][bj][m][1];
                    if (MODE == 0) { v0 = v0 * rs * gv[bj][0]; v1 = v1 * rs * gv[bj][1]; }
                    if (MODE == 2) {
#if SILU_PK
                        v0 = silu4(v0); v1 = silu4(v1);
#else
#pragma unroll
                        for (int j = 0; j < 4; ++j) { v0[j] = silu_f(v0[j]); v1[j] = silu_f(v1[j]); }
#endif
                    }
                    u32x4 w; w.x = cvt_pk_bf16(v0[0], v0[1]); w.y = cvt_pk_bf16(v0[2], v0[3]); w.z = cvt_pk_bf16(v1[0], v1[1]); w.w = cvt_pk_bf16(v1[2], v1[3]);
#if DIRECT_EPI2
                    *(u32x4*)(base + (size_t)(rowt + ai * HALF + m * 16 + fr) * ldc + colw + 8 * fq + 32 * bj) = w;
#else
                    *(PG8_LAS u32x4*)(wp + bj * 64) = w;
#endif
                }
#if DIRECT_EPI2
                continue;
#endif
                const u32x4 t0 = *(const PG8_LAS u32x4*)(rp), t1 = *(const PG8_LAS u32x4*)(rp + 8 * 144);
                bf16_t* rowp = base + (size_t)(rowt + ai * HALF + m * 16 + rr) * ldc + colw + cc * 8;
#if WT_STORES
                asm volatile("global_store_dwordx4 %0, %1, off sc1\n\ts_nop 1" :: "v"(rowp), "v"(t0) : "memory");
                asm volatile("global_store_dwordx4 %0, %1, off sc1\n\ts_nop 1" :: "v"(rowp + (size_t)8 * ldc), "v"(t1) : "memory");
#elif NT_PROJ
                __builtin_nontemporal_store(t0, (u32x4*)(rowp)); __builtin_nontemporal_store(t1, (u32x4*)(rowp + (size_t)8 * ldc));
#else
                if (NOFENCE && wt) {
                    asm volatile("global_store_dwordx4 %0, %1, off sc1\n\ts_nop 1" :: "v"(rowp), "v"(t0) : "memory");
                    asm volatile("global_store_dwordx4 %0, %1, off sc1\n\ts_nop 1" :: "v"(rowp + (size_t)8 * ldc), "v"(t1) : "memory");
                } else { *(u32x4*)(rowp) = t0; *(u32x4*)(rowp + (size_t)8 * ldc) = t1; }
#endif
            }
    }
    __device__ __forceinline__ void operator()(const f32x4 (&acc)[2][2][4][2], const Unit& u, int wr, int wc, int fr, int fq) const {
        const int pn = u.pn, rowt = u.pm * BM + wr * 64, cw = wc * 64;
#if SHADOW_EPI2 == 1
        if (u.sh) { float keep = 0.f;
#pragma unroll
            for (int ai = 0; ai < 2; ++ai)
#pragma unroll
                for (int bj = 0; bj < 2; ++bj)
#pragma unroll
                    for (int m = 0; m < 4; ++m)
#pragma unroll
                        for (int n = 0; n < 2; ++n) asm volatile("" :: "v"(acc[ai][bj][m][n]));
            return; }
#endif
        PG8_LAS unsigned char* patch = xl + (wr * 4 + wc) * 3072;
        const bool wt = NOFENCE && (u.pm & 15) >= 14;
        if (pn < 2)      run<0>(acc, Q, 512, pn * 256 + cw, rowt, qg, qscale, fr, fq, patch);
        else if (pn < 4) run<0>(acc, Kb, 512, (pn - 2) * 256 + cw, rowt, kg, 1.0f, fr, fq, patch, wt);
        else if (pn < 6) run<1>(acc, V, 512, (pn - 4) * 256 + cw, rowt, nullptr, 1.0f, fr, fq, patch, wt);
        else if (pn < 8) run<1>(acc, U, 512, (pn - 6) * 256 + cw, rowt, nullptr, 1.0f, fr, fq, patch, wt);
        else             run<2>(acc, SZ, 1024, (pn - 8) * 256 + cw, rowt, nullptr, 1.0f, fr, fq, patch);
    }
};
struct EpiOut {
    static constexpr bool PERM = true, AFTER_DRAIN = false, HEADPERM = true, XPF = (X_PF_LOOP != 0); static constexpr int NST = 32;
    __device__ __forceinline__ void pf(const Unit& u, int sp, int wid, int lane, unsigned& pfreg) const {
        if (wid == (sp & 7)) {
            const int idx = sp * 64 + lane;
            const float* p = x + (size_t)(u.pm * BM + (idx >> 3)) * 1024 + u.pn * BM + (idx & 7) * 32;
            asm volatile("global_load_dword %0, %1, off" : "+v"(pfreg) : "v"(p) : "memory");
        }
    }
    const float* x; float* out; const float* modf; int seq; PG8_LAS unsigned char* xl;
    float* out_sh = nullptr;
    const bf16_t* xb = nullptr;
    __device__ __forceinline__ void operator()(const f32x4 (&acc)[2][2][4][2], const Unit& u, int wr, int wc, int fr, int fq) const {
#if SHADOW_EPI4 == 1
        if (u.sh) {
#pragma unroll
            for (int ai = 0; ai < 2; ++ai)
#pragma unroll
                for (int bj = 0; bj < 2; ++bj)
#pragma unroll
                    for (int m = 0; m < 4; ++m)
#pragma unroll
                        for (int n = 0; n < 2; ++n) asm volatile("" :: "v"(acc[ai][bj][m][n]));
            return; }
#endif
        const int b = (u.pm * BM) / seq; const float* gate = modf + b * 3072 + 2048;
#if SHADOW_EPI4 >= 2
        float* const out = u.sh ? this->out_sh : this->out;
#endif
        const int lane = fq * 16 + fr, rr = lane >> 3, cc = lane & 7;
        const int col0 = u.pn * BM + wc * 64;
        PG8_LAS unsigned char* patch = xl + (wr * 4 + wc) * 3072;
        PG8_LAS unsigned char* wp = patch + fr * 144 + fq * 32;
        const PG8_LAS unsigned char* rp = patch + rr * 144 + cc * 16;
        f32x4 gv[2][2];
#pragma unroll
        for (int bj = 0; bj < 2; ++bj)
#pragma unroll
            for (int n = 0; n < 2; ++n) gv[bj][n] = *(const f32x4*)(gate + col0 + 8 * fq + 32 * bj + 4 * n);
#if XB_RESID
#pragma unroll
        for (int ai = 0; ai < 2; ++ai) {
            const size_t r0 = (size_t)(u.pm * BM + ai * HALF + wr * 64);
            u32x4 xq[4][2];
#pragma unroll
            for (int m = 0; m < 4; ++m)
#pragma unroll
                for (int i = 0; i < 2; ++i) xq[m][i] = __builtin_nontemporal_load((const u32x4*)(xb + (r0 + m * 16 + rr + 8 * i) * 1024 + col0 + 8 * cc));
            const size_t rbase = r0 * 1024 + col0 + cc * 4;
#pragma unroll
            for (int m = 0; m < 4; ++m) {
                *(PG8_LAS u32x4*)(patch + rr * 144 + cc * 16) = xq[m][0]; *(PG8_LAS u32x4*)(patch + (rr + 8) * 144 + cc * 16) = xq[m][1];
                typedef unsigned u32x2_t __attribute__((ext_vector_type(2)));
                u32x2_t xs[2][2];
#pragma unroll
                for (int bj = 0; bj < 2; ++bj)
#pragma unroll
                    for (int i = 0; i < 2; ++i) xs[bj][i] = *(const PG8_LAS u32x2_t*)(patch + (rr + 8 * i) * 144 + 64 * bj + 8 * cc);
#pragma unroll
                for (int bj = 0; bj < 2; ++bj) {
                    *(PG8_LAS f32x4*)(wp) = gv[bj][0] * acc[ai][bj][m][0]; *(PG8_LAS f32x4*)(wp + 16) = gv[bj][1] * acc[ai][bj][m][1];
                    const f32x4 t0 = *(const PG8_LAS f32x4*)(rp), t1 = *(const PG8_LAS f32x4*)(rp + 8 * 144);
                    const f32x4 x0 = {__builtin_bit_cast(float, xs[bj][0][0] << 16), __builtin_bit_cast(float, xs[bj][0][0] & 0xffff0000u), __builtin_bit_cast(float, xs[bj][0][1] << 16), __builtin_bit_cast(float, xs[bj][0][1] & 0xffff0000u)};
                    const f32x4 x1 = {__builtin_bit_cast(float, xs[bj][1][0] << 16), __builtin_bit_cast(float, xs[bj][1][0] & 0xffff0000u), __builtin_bit_cast(float, xs[bj][1][1] << 16), __builtin_bit_cast(float, xs[bj][1][1] & 0xffff0000u)};
                    __builtin_nontemporal_store(x0 + t0, (f32x4*)(out + rbase + (size_t)(m * 16 + rr) * 1024 + 32 * bj));
                    __builtin_nontemporal_store(x1 + t1, (f32x4*)(out + rbase + (size_t)(m * 16 + rr + 8) * 1024 + 32 * bj));
                }
            }
            asm volatile("" ::: "memory");
        }
#elif EPI4_ROLL
        const size_t rb0 = (size_t)(u.pm * BM + wr * 64 + rr) * 1024 + col0 + cc * 4;
        f32x4 xv[4][2][2];
#define EPI4_ISSUE(q) do { const size_t rq_ = rb0 + (size_t)(((q) >> 2) * HALF + ((q) & 3) * 16) * 1024; _Pragma("unroll") for (int bj = 0; bj < 2; ++bj) _Pragma("unroll") for (int i = 0; i < 2; ++i) \
            xv[(q) & 3][bj][i] = __builtin_nontemporal_load((const f32x4*)(x + rq_ + (size_t)(8 * i) * 1024 + 32 * bj)); } while (0)
#pragma unroll
        for (int q = 0; q < 4; ++q) EPI4_ISSUE(q);
        __builtin_amdgcn_sched_barrier(0);
#pragma unroll
        for (int q = 0; q < 8; ++q) {
            const int ai = q >> 2, m = q & 3;
            const size_t rq = rb0 + (size_t)(ai * HALF + m * 16) * 1024;
#pragma unroll
            for (int bj = 0; bj < 2; ++bj) {
                *(PG8_LAS f32x4*)(wp) = gv[bj][0] * acc[ai][bj][m][0]; *(PG8_LAS f32x4*)(wp + 16) = gv[bj][1] * acc[ai][bj][m][1];
                const f32x4 t0 = *(const PG8_LAS f32x4*)(rp), t1 = *(const PG8_LAS f32x4*)(rp + 8 * 144);
                __builtin_nontemporal_store(xv[q & 3][bj][0] + t0, (f32x4*)(out + rq + 32 * bj));
                __builtin_nontemporal_store(xv[q & 3][bj][1] + t1, (f32x4*)(out + rq + (size_t)8 * 1024 + 32 * bj));
            }
            if (q + 4 < 8) EPI4_ISSUE(q + 4);
        }
#undef EPI4_ISSUE
#else
#pragma unroll
        for (int ai = 0; ai < 2; ++ai) {
            const size_t rbase = (size_t)(u.pm * BM + ai * HALF + wr * 64) * 1024 + col0 + cc * 4;
            f32x4 xv[4][2][2];
#pragma unroll
            for (int m = 0; m < 4; ++m)
#pragma unroll
                for (int bj = 0; bj < 2; ++bj)
#pragma unroll
                    for (int i = 0; i < 2; ++i) {
#if SHADOW_EPI4 == 2
                        if (u.sh) { xv[m][bj][i] = (f32x4){0.f, 0.f, 0.f, 0.f}; asm volatile("" : "+v"(xv[m][bj][i])); continue; }
#endif
                        xv[m][bj][i] = __builtin_nontemporal_load((const f32x4*)(x + rbase + (size_t)(m * 16 + rr + 8 * i) * 1024 + 32 * bj)); }
#pragma unroll
            for (int m = 0; m < 4; ++m)
#pragma unroll
                for (int bj = 0; bj < 2; ++bj) {
                    *(PG8_LAS f32x4*)(wp) = gv[bj][0] * acc[ai][bj][m][0]; *(PG8_LAS f32x4*)(wp + 16) = gv[bj][1] * acc[ai][bj][m][1];
                    const f32x4 t0 = *(const PG8_LAS f32x4*)(rp), t1 = *(const PG8_LAS f32x4*)(rp + 8 * 144);
#ifdef OUT_POL
                    { const f32x4 o0_ = xv[m][bj][0] + t0, o1_ = xv[m][bj][1] + t1;
                      asm volatile("global_store_dwordx4 %0, %1, off " OUT_POL "\n\ts_nop 1" :: "v"(out + rbase + (size_t)(m * 16 + rr) * 1024 + 32 * bj), "v"(o0_) : "memory");
                      asm volatile("global_store_dwordx4 %0, %1, off " OUT_POL "\n\ts_nop 1" :: "v"(out + rbase + (size_t)(m * 16 + rr + 8) * 1024 + 32 * bj), "v"(o1_) : "memory"); }
#else
                    __builtin_nontemporal_store(xv[m][bj][0] + t0, (f32x4*)(out + rbase + (size_t)(m * 16 + rr) * 1024 + 32 * bj));
                    __builtin_nontemporal_store(xv[m][bj][1] + t1, (f32x4*)(out + rbase + (size_t)(m * 16 + rr + 8) * 1024 + 32 * bj));
#endif
                }
            asm volatile("" ::: "memory");
        }
#endif
    }
};

template <class Epi, class Sched, bool ALIGN_EPI = false, bool SP2 = false>
__device__ __forceinline__ void gemm_phase(PG8_LAS unsigned char* lds, const Gemm g, const Sched& S, const Epi& E) {
    int tid_ = threadIdx.x;
#if GEMM_OPAQUE_TID
    asm volatile("" : "+v"(tid_));
#endif
    const int tid = tid_, wid = __builtin_amdgcn_readfirstlane(tid >> 6), lane = tid & 63, wr = wid >> 2, wc = wid & 3, fr = lane & 15, fq = lane >> 4;
    const int K = g.K, nt = K / BK;
    unsigned voffA[2], voffB[2];
#pragma unroll
    for (int i = 0; i < 2; ++i) { int R, C; stage_rc(tid * 16 + i * 8192, R, C); const int Rb = Epi::HEADPERM ? (64 * (R >> 5) + perm32(R & 31)) : (Epi::PERM ? ((R & ~31) + perm32(R & 31)) : R);
        voffA[i] = (unsigned)(R * K + C) * 2u; voffB[i] = (unsigned)(Rb * K + C) * 2u; }
    const size_t kstep = (size_t)(BK * 2);
    const size_t hstep = (size_t)HALF * K * 2;
    const size_t hstepB = Epi::HEADPERM ? (size_t)32 * K * 2 : hstep;
    const size_t tstep = 2 * hstep;
    const unsigned ldsw = (unsigned)wid * 1024u;
    const int aoff = lds_byte(wr * 64 + fr, fq * 8), boff = lds_byte(wc * 32 + fr, fq * 8);
#define PG8_SA(b, h) (((b) * 2 + (h)) * HTB)
#define PG8_SB(b, h) ((4 + (b) * 2 + (h)) * HTB)
#define PG8_STAGE(bufoff, gbase, voff) do { if (SHADOW_NODMA && cur.sh) break; _Pragma("unroll") for (int _i = 0; _i < 2; ++_i) \
        __builtin_amdgcn_global_load_lds((const unsigned*)((const char*)(gbase) + (voff)[_i]), (PG8_LAS unsigned*)(lds + (bufoff) + ldsw + _i * 8192), 16, 0, 0); } while (0)
#define PG8_LDA(dst, b, h) do { _Pragma("unroll") for (int m = 0; m < 4; ++m) _Pragma("unroll") for (int k = 0; k < 2; ++k) dst[m][k] = *(const PG8_LAS bf16x8*)(lds + PG8_SA(b, h) + aoff + m * 2048 + k * 1024); } while (0)
#define PG8_LDB(dst, b, h) do { _Pragma("unroll") for (int n = 0; n < 2; ++n) _Pragma("unroll") for (int k = 0; k < 2; ++k) dst[n][k] = *(const PG8_LAS bf16x8*)(lds + PG8_SB(b, h) + boff + n * 2048 + k * 1024); } while (0)
#define PG8_MMA(ai, bj, At, Bt) do { __builtin_amdgcn_s_setprio(1); _Pragma("unroll") for (int m = 0; m < 4; ++m) _Pragma("unroll") for (int n = 0; n < 2; ++n) _Pragma("unroll") for (int k = 0; k < 2; ++k) \
        acc[ai][bj][m][n] = __builtin_amdgcn_mfma_f32_16x16x32_bf16(Bt[n][k], At[m][k], acc[ai][bj][m][n], 0, 0, 0); __builtin_amdgcn_s_setprio(0); } while (0)
#define PG8_WAIT_V(n) asm volatile("s_waitcnt vmcnt(" #n ")" ::: "memory")
#define PG8_WAIT_L(n) asm volatile("s_waitcnt lgkmcnt(" #n ")" ::: "memory")
#define PG8_BAR __builtin_amdgcn_s_barrier()
#define PG8_SCHED __builtin_amdgcn_sched_barrier(0)
#define PG8_PF(sp) do { if constexpr (Epi::XPF) E.pf(cur, (sp), wid, lane, pfreg); } while (0)
    constexpr bool EARLY = SP2 && ALIGN_EPI && (EARLY_A11 != 0); bool follow = false;
#define PG8_WAIT_SEL do { if constexpr (EARLY) asm volatile("s_waitcnt vmcnt(%1)\n\ts_cmp_lg_u32 %0, 0\n\ts_cbranch_scc1 1\n\ts_waitcnt vmcnt(8)" :: "s"(rl), "n"(10 + Epi::NST) : "memory", "scc"); else PG8_WAIT_V(8); } while (0)
    unsigned pfreg = 0u;
    Unit cur, nxt; int ui = 0;
    if (!S.next(0, cur)) return;
    f32x4 acc[2][2][4][2];
#pragma unroll
    for (int a = 0; a < 2; ++a)
#pragma unroll
        for (int b = 0; b < 2; ++b)
#pragma unroll
            for (int m = 0; m < 4; ++m)
#pragma unroll
                for (int n = 0; n < 2; ++n) acc[a][b][m][n] = (f32x4){0.f, 0.f, 0.f, 0.f};
    bf16x8 At[4][2], B0[2][2], B1[2][2];
    const char* cA = (const char*)g.A + (size_t)cur.pm * tstep; const char* cB = (const char*)g.Bt + (size_t)cur.pn * tstep;
    S.a_ready(cur);
    if constexpr (SP2) {
        PG8_STAGE(PG8_SB(0, 0), cB, voffB); PG8_STAGE(PG8_SB(0, 1), cB + hstepB, voffB); PG8_STAGE(PG8_SA(0, 0), cA, voffA); PG8_STAGE(PG8_SA(0, 1), cA + hstep, voffA);
        if (wr == 1) PG8_BAR;
        PG8_WAIT_V(2); PG8_BAR;
        PG8_STAGE(PG8_SB(1, 0), cB + kstep, voffB); PG8_STAGE(PG8_SA(1, 0), cA + kstep, voffA); PG8_STAGE(PG8_SB(1, 1), cB + hstepB + kstep, voffB);
        PG8_WAIT_V(6); PG8_BAR;
    } else {
        PG8_STAGE(PG8_SB(0, 0), cB, voffB); PG8_STAGE(PG8_SA(0, 0), cA, voffA); PG8_STAGE(PG8_SB(0, 1), cB + hstepB, voffB); PG8_STAGE(PG8_SA(0, 1), cA + hstep, voffA);
        if (wr == 1) PG8_BAR;
        PG8_WAIT_V(4); PG8_BAR;
        PG8_STAGE(PG8_SB(1, 0), cB + kstep, voffB); PG8_STAGE(PG8_SA(1, 0), cA + kstep, voffA); PG8_STAGE(PG8_SB(1, 1), cB + hstepB + kstep, voffB);
        PG8_WAIT_V(6); PG8_BAR;
    }
    for (;;) {
        const bool has_next = S.next(ui + 1, nxt);
        const char* nA = has_next ? (const char*)g.A + (size_t)nxt.pm * tstep : cA; const char* nB = has_next ? (const char*)g.Bt + (size_t)nxt.pn * tstep : cB;
        unsigned midv = 16u;
        for (int t = 0; t < nt; t += 2) {
            const bool last = (t == nt - 2);
            const char* a1 = cA + (size_t)(t + 1) * kstep;
            const char* a2 = last ? nA : cA + (size_t)(t + 2) * kstep; const char* b2 = last ? nB : cB + (size_t)(t + 2) * kstep;
            const char* a3 = a2 + kstep; const char* b3 = b2 + kstep;
            if (last && has_next) S.a_ready(nxt);
            if constexpr (Sched::MIDK) { if (t == 4) midv = S.mid_peek(cur); if (t == 6) S.mid_ready(cur, midv); }
            const int rl = __builtin_amdgcn_readfirstlane((follow && t == 0) ? 1 : 0);
            if constexpr (SP2) {
            PG8_LDB(B0, 0, 0); PG8_LDB(B1, 0, 1); PG8_SCHED; PG8_LDA(At, 0, 0);
            PG8_STAGE(PG8_SA(1, 1), a1 + hstep, voffA);
            PG8_WAIT_SEL;
            PG8_WAIT_L(0); PG8_BAR; PG8_PF(2 * t); PG8_MMA(0, 0, At, B0); PG8_MMA(0, 1, At, B1); PG8_BAR; PG8_SCHED;
            PG8_LDA(At, 0, 1); PG8_STAGE(PG8_SB(0, 0), b2, voffB); PG8_STAGE(PG8_SB(0, 1), b2 + hstepB, voffB); PG8_STAGE(PG8_SA(0, 0), a2, voffA);
            PG8_WAIT_SEL;
            PG8_WAIT_L(0); PG8_BAR; PG8_PF(2 * t + 1); PG8_MMA(1, 0, At, B0); PG8_MMA(1, 1, At, B1); PG8_BAR; PG8_SCHED;
            PG8_LDB(B0, 1, 0); PG8_LDB(B1, 1, 1); PG8_SCHED; PG8_LDA(At, 1, 0); PG8_STAGE(PG8_SA(0, 1), a2 + hstep, voffA);
            PG8_WAIT_SEL;
            PG8_WAIT_L(0); PG8_BAR; PG8_PF(2 * t + 2); PG8_MMA(0, 0, At, B0); PG8_MMA(0, 1, At, B1); PG8_BAR; PG8_SCHED;
            PG8_LDA(At, 1, 1); PG8_STAGE(PG8_SB(1, 0), b3, voffB); PG8_STAGE(PG8_SB(1, 1), b3 + hstepB, voffB); PG8_STAGE(PG8_SA(1, 0), a3, voffA);
            PG8_WAIT_V(8); PG8_WAIT_L(0); PG8_BAR; PG8_PF(2 * t + 3); PG8_MMA(1, 0, At, B0); PG8_MMA(1, 1, At, B1); PG8_BAR; PG8_SCHED;
            } else {
            PG8_LDB(B0, 0, 0); PG8_SCHED; PG8_LDA(At, 0, 0); PG8_STAGE(PG8_SA(1, 1), a1 + hstep, voffA);
            PG8_WAIT_L(8); PG8_BAR; PG8_WAIT_L(0); PG8_MMA(0, 0, At, B0); PG8_BAR; PG8_SCHED;
            PG8_LDB(B1, 0, 1); PG8_STAGE(PG8_SB(0, 0), b2, voffB);
            PG8_BAR; PG8_WAIT_L(0); PG8_MMA(0, 1, At, B1); PG8_BAR;
            PG8_LDA(At, 0, 1); PG8_STAGE(PG8_SA(0, 0), a2, voffA);
            PG8_BAR; PG8_WAIT_L(0); PG8_MMA(1, 0, At, B0); PG8_BAR; PG8_SCHED;
            PG8_STAGE(PG8_SB(0, 1), b2 + hstepB, voffB);
            PG8_WAIT_V(6); PG8_BAR; PG8_MMA(1, 1, At, B1); PG8_BAR;
            PG8_LDB(B0, 1, 0); PG8_SCHED; PG8_LDA(At, 1, 0); PG8_STAGE(PG8_SA(0, 1), a2 + hstep, voffA);
            PG8_WAIT_L(8); PG8_BAR; PG8_WAIT_L(0); PG8_MMA(0, 0, At, B0); PG8_BAR; PG8_SCHED;
            PG8_LDB(B1, 1, 1); PG8_STAGE(PG8_SB(1, 0), b3, voffB);
            PG8_BAR; PG8_WAIT_L(0); PG8_MMA(0, 1, At, B1); PG8_BAR;
            PG8_LDA(At, 1, 1); PG8_STAGE(PG8_SA(1, 0), a3, voffA);
            PG8_BAR; PG8_WAIT_L(0); PG8_MMA(1, 0, At, B0); PG8_BAR; PG8_SCHED;
            PG8_STAGE(PG8_SB(1, 1), b3 + hstepB, voffB);
            PG8_WAIT_V(6); PG8_BAR; PG8_MMA(1, 1, At, B1); PG8_BAR;
            }
        }
        if constexpr (ALIGN_EPI) { if (wr == 0) PG8_BAR; }
        if constexpr (EARLY) { if (has_next) { PG8_STAGE(PG8_SA(1, 1), nA + kstep + hstep, voffA); } follow = has_next; }
        if constexpr (!Epi::AFTER_DRAIN) { E(acc, cur, wr, wc, fr, fq); S.done(cur); }
        if (!has_next) break;
#pragma unroll
        for (int a = 0; a < 2; ++a)
#pragma unroll
            for (int b = 0; b < 2; ++b)
#pragma unroll
                for (int m = 0; m < 4; ++m)
#pragma unroll
                    for (int n = 0; n < 2; ++n) acc[a][b][m][n] = (f32x4){0.f, 0.f, 0.f, 0.f};
        cur = nxt; cA = nA; cB = nB; ++ui;
        if constexpr (ALIGN_EPI) { if (wr == 1) PG8_BAR; }
    }
    PG8_WAIT_V(0);
    if constexpr (Epi::XPF) asm volatile("" :: "v"(pfreg));
    if constexpr (!ALIGN_EPI) { if (wr == 0) PG8_BAR; }
    PG8_BAR;
    if constexpr (Epi::AFTER_DRAIN) { E.fused(acc, cur, wr, wc, fr, fq, lds, wid, lane); S.done(cur); }
#undef PG8_PF
#undef PG8_WAIT_SEL
#undef PG8_SA
#undef PG8_SB
#undef PG8_STAGE
#undef PG8_LDA
#undef PG8_LDB
#undef PG8_MMA
#undef PG8_WAIT_V
#undef PG8_WAIT_L
#undef PG8_BAR
#undef PG8_SCHED
}
}
#ifndef PG8_SP2
#define PG8_SP2 true
#endif
#ifndef PG8_ALIGN
#define PG8_ALIGN true
#endif
namespace att {
using bf16 = __hip_bfloat16;
using bf16x8 = __attribute__((ext_vector_type(8))) short;
using s16x4 = __attribute__((ext_vector_type(4))) short;
using f32x16 = __attribute__((ext_vector_type(16))) float;
using f32x4 = __attribute__((ext_vector_type(4))) float;
using u32x4 = __attribute__((ext_vector_type(4))) unsigned;
#define ALAS __attribute__((address_space(3)))
typedef ALAS const char* lds_cptr;
typedef short v4i16_t __attribute__((ext_vector_type(4)));
constexpr int NSLOT = 6, SLOTB = 16384, VOFF = 8192;
constexpr int TB_COPY = 656, TB_FLOATS = 4 * TB_COPY, TBG_STRIDE = 2688, TB_ORG = 576;
constexpr int L_RING = 0, L_TB = NSLOT * SLOTB, L_WS = L_TB + TB_FLOATS * 4, L_OST = L_WS + 2048, L_END = L_OST + 8 * 4096;
constexpr int UNIT_ROWS = 256, NUNITS = BATCH * NHEAD * (SEQ / UNIT_ROWS);
__device__ __forceinline__ int crow(int r, int hi) { return (r & 3) + 8 * (r >> 2) + 4 * hi; }
__device__ __forceinline__ void glds16(const void* gsrc, unsigned lds_dst) { unsigned keep;
    asm volatile("s_mov_b32 %0, m0\n\ts_mov_b32 m0, %2\n\ts_nop 0\n\tglobal_load_lds_dwordx4 %1, off" ATT_DMA_POL "\n\ts_mov_b32 m0, %0" : "=&s"(keep) : "v"(gsrc), "s"(lds_dst) : "memory"); }
typedef float f32x2_t __attribute__((ext_vector_type(2))); typedef __bf16 bf16x2_t __attribute__((ext_vector_type(2)));
__device__ __forceinline__ unsigned cvtpk_s(float lo, float hi) { f32x2_t v = {lo, hi}; bf16x2_t b = __builtin_convertvector(v, bf16x2_t); return __builtin_bit_cast(unsigned, b); }
__device__ __forceinline__ s16x4 vtr(lds_cptr p) { return __builtin_bit_cast(s16x4, __builtin_amdgcn_ds_read_tr16_b64_v4i16((ALAS v4i16_t*)p)); }
__device__ __forceinline__ float bf_lo(unsigned w) { return __builtin_bit_cast(float, w << 16); }
__device__ __forceinline__ float bf_hi(unsigned w) { return __builtin_bit_cast(float, w & 0xffff0000u); }
#define ATT_WAIT_BAR(N) asm volatile("s_waitcnt vmcnt(" #N ") lgkmcnt(0)\n\ts_barrier" ::: "memory")
#define ATT_MFMA(a, b, c) __builtin_amdgcn_mfma_f32_32x32x16_bf16(a, b, c, 0, 0, 0)

#if SZ_PLAIN
#define SZ_LOAD(p) (*(p))
#else
#define SZ_LOAD(p) __builtin_nontemporal_load(p)
#endif
struct Tensors { const bf16* Q; const bf16* K; const bf16* V; const bf16* U; const bf16* SZ; bf16* Y; const float* tbg; };

__device__ __forceinline__ void load_zq(u32x4 (&zq)[4], const Tensors& T, long qrow0, int h, int lane) {
#pragma unroll
    for (int i = 0; i < 4; ++i) zq[i] = SZ_LOAD((const u32x4*)(T.SZ + (size_t)(qrow0 + i * 8 + (lane >> 3)) * 1024 + h * 64 + (lane & 7) * 8));
}
__device__ __forceinline__ void unit_epilogue(float lsum, const f32x16& o0, const f32x16& o1, long qrow0, int h, int wid, int lane, int r32, int hi, const Tensors& T, lds_cptr l3, const u32x4 (&zq)[4]) {
    { auto rr = __builtin_amdgcn_permlane32_swap(__float_as_uint(lsum), __float_as_uint(lsum), false, false); lsum = __uint_as_float(rr[0]) + __uint_as_float(rr[1]); }
    ALAS float* wsf = (ALAS float*)(l3 + L_WS) + wid * 64;
    if (hi == 0) wsf[r32] = lsum;
    asm volatile("s_waitcnt lgkmcnt(0)" ::: "memory");
    float rli[16];
#pragma unroll
    for (int r = 0; r < 16; ++r) rli[r] = __builtin_amdgcn_rcpf(wsf[crow(r, hi)]);
    ALAS unsigned short* stg = (ALAS unsigned short*)(l3 + L_OST) + wid * 2048;
#pragma unroll
    for (int r = 0; r < 16; ++r) { const int orow = crow(r, hi);
        stg[orow * 64 + r32] = (unsigned short)(cvtpk_s(o0[r] * rli[r], 0.f) & 0xffffu);
        stg[orow * 64 + 32 + r32] = (unsigned short)(cvtpk_s(o1[r] * rli[r], 0.f) & 0xffffu); }
    asm volatile("s_waitcnt lgkmcnt(0)" ::: "memory");
    {
#pragma unroll
      for (int i = 0; i < 4; ++i) { const int row = i * 8 + (lane >> 3), ch = lane & 7;
        const u32x4 v = *(const ALAS u32x4*)(stg + row * 64 + ch * 8);
        const size_t go = (size_t)(qrow0 + row) * 1024 + h * 64 + ch * 8;
        u32x4 w;
#pragma unroll
        for (int j = 0; j < 4; ++j) w[j] = cvtpk_s(bf_lo(v[j]) * bf_lo(zq[i][j]), bf_hi(v[j]) * bf_hi(zq[i][j]));
        *(u32x4*)(T.Y + go) = w; } }
    asm volatile("s_waitcnt lgkmcnt(0)\n\ts_barrier" ::: "memory");
}

__device__ __forceinline__ void attn_unit(int b, int h, int m4, const Tensors& T, char* lds) {
    int tid = threadIdx.x; asm volatile("" : "+v"(tid));
    const int lane = tid & 63, r32 = lane & 31, hi = lane >> 5;
    const int wid = __builtin_amdgcn_readfirstlane(tid >> 6), grp = wid >> 1, hf = wid & 1;
    const long rowbase = (long)b * SEQ;
    const int c = 4 * m4 + grp;
    const long qrow0 = rowbase + 64 * c + 32 * hf;
    const unsigned lds0 = (unsigned)(uintptr_t)lds;
    const lds_cptr l3 = (lds_cptr)lds;
    const float* tg = T.tbg + h * TBG_STRIDE;
    for (int i = tid; i < TB_FLOATS / 4; i += 512) ((ALAS f32x4*)(l3 + L_TB))[i] = ((const f32x4*)tg)[i];
    const float cfar = tg[TB_FLOATS];
    const bf16* Qw = T.Q + (qrow0 + r32) * 512 + h * 64 + hi * 8;
    bf16x8 qr[4];
#pragma unroll
    for (int d0 = 0; d0 < 4; ++d0) qr[d0] = *reinterpret_cast<const bf16x8*>(Qw + d0 * 16);
    const bf16* ksrc = T.K + (rowbase + lane) * 512 + h * 64 + wid * 8;
    const bf16* vsrc = T.V + (rowbase + 16 * (wid & 3) + (lane >> 2)) * 512 + h * 64 + (wid >> 2) * 32 + (lane & 3) * 8;
    const unsigned kdst = lds0 + L_RING + wid * 1024, vdst = kdst + VOFF;
#define ATT_DMA(i) do { int tau_ = 4 * m4 - 8 + (i); tau_ = tau_ < 0 ? 0 : tau_; const unsigned so_ = (unsigned)(((i) % NSLOT) * SLOTB); \
        glds16(ksrc + (long)tau_ * (64 * 512), (unsigned)__builtin_amdgcn_readfirstlane(kdst + so_)); glds16(vsrc + (long)tau_ * (64 * 512), (unsigned)__builtin_amdgcn_readfirstlane(vdst + so_)); } while (0)
    const int k0 = (m4 == 0) ? 5 : (m4 == 1 ? 1 : 0);
    ATT_DMA(k0); ATT_DMA(k0 + 1); ATT_DMA(k0 + 2); ATT_DMA(k0 + 3); ATT_DMA(k0 + 4);
    const int s = (4 - (r32 & 3)) & 3;
    const int e0 = TB_ORG - 32 * hf - r32 + 4 * hi - s;
    const lds_cptr tb0 = l3 + L_TB + s * (TB_COPY * 4) + e0 * 4;
    const lds_cptr kp0 = l3 + L_RING + hi * 1024 + r32 * 16;
    const lds_cptr vp0 = l3 + L_RING + VOFF + ((lane >> 4) & 1) * 32 + (lane & 3) * 8 + (4 * hi + ((lane & 15) >> 2)) * 64;
    f32x16 o0 = f32x16{}, o1 = f32x16{}; float lsum = 0.f;
    f32x16 cf;
#pragma unroll
    for (int r = 0; r < 16; ++r) cf[r] = cfar;
    asm volatile("" : "+v"(cf));
#pragma unroll 1
    for (int k = k0; k < 9; ++k) {
        if (k < 8) ATT_WAIT_BAR(2); else ATT_WAIT_BAR(0);
        if (k + 5 < 12) ATT_DMA(k + 5);
        const int Tt = 4 * m4 + grp - 8 + k;
        if (Tt >= 0) {
            const int so = ((k + grp) % NSLOT) * SLOTB;
            const lds_cptr kp = kp0 + so;
            bf16x8 kf[8];
#pragma unroll
            for (int d0 = 0; d0 < 4; ++d0) { kf[2 * d0] = *(const ALAS bf16x8*)(kp + d0 * 2048); kf[2 * d0 + 1] = *(const ALAS bf16x8*)(kp + d0 * 2048 + 512); }
            f32x16 p0, p1;
            if (k >= 4) {
                const lds_cptr tp = tb0 - 256 * (8 - k);
#pragma unroll
                for (int g = 0; g < 4; ++g) { const f32x4 a = *(const ALAS f32x4*)(tp + 32 * g), bq = *(const ALAS f32x4*)(tp + 32 * (g + 4));
#pragma unroll
                    for (int j = 0; j < 4; ++j) { p0[4 * g + j] = a[j]; p1[4 * g + j] = bq[j]; } }
            } else { p0 = cf; p1 = cf; }
#pragma unroll
            for (int d0 = 0; d0 < 4; ++d0) { p0 = ATT_MFMA(kf[2 * d0], qr[d0], p0); p1 = ATT_MFMA(kf[2 * d0 + 1], qr[d0], p1); }
#pragma unroll
            for (int r = 0; r < 16; ++r) { p0[r] = __builtin_amdgcn_exp2f(p0[r]); p1[r] = __builtin_amdgcn_exp2f(p1[r]); }
            float sa = 0.f, sb = 0.f;
#pragma unroll
            for (int r = 0; r < 16; ++r) { sa += p0[r]; sb += p1[r]; }
            lsum += sa + sb;
            u32x4 pw0, pw1, pw2, pw3;
#define ATT_PKW(P, B) cvtpk_s(P[B], P[(B) + 1])
            pw0 = (u32x4){ATT_PKW(p0, 0), ATT_PKW(p0, 2), ATT_PKW(p0, 4), ATT_PKW(p0, 6)}; pw1 = (u32x4){ATT_PKW(p0, 8), ATT_PKW(p0, 10), ATT_PKW(p0, 12), ATT_PKW(p0, 14)};
            pw2 = (u32x4){ATT_PKW(p1, 0), ATT_PKW(p1, 2), ATT_PKW(p1, 4), ATT_PKW(p1, 6)}; pw3 = (u32x4){ATT_PKW(p1, 8), ATT_PKW(p1, 10), ATT_PKW(p1, 12), ATT_PKW(p1, 14)};
#undef ATT_PKW
            const lds_cptr vp = vp0 + so;
#define ATT_VFR(d0, ks) ({ const s16x4 lo_ = vtr(vp + (d0) * 4096 + (ks) * 1024), hi_ = vtr(vp + (d0) * 4096 + (ks) * 1024 + 512); (bf16x8){lo_[0], lo_[1], lo_[2], lo_[3], hi_[0], hi_[1], hi_[2], hi_[3]}; })
            o0 = ATT_MFMA(__builtin_bit_cast(bf16x8, pw0), ATT_VFR(0, 0), o0); o1 = ATT_MFMA(__builtin_bit_cast(bf16x8, pw0), ATT_VFR(1, 0), o1);
            o0 = ATT_MFMA(__builtin_bit_cast(bf16x8, pw1), ATT_VFR(0, 1), o0); o1 = ATT_MFMA(__builtin_bit_cast(bf16x8, pw1), ATT_VFR(1, 1), o1);
            o0 = ATT_MFMA(__builtin_bit_cast(bf16x8, pw2), ATT_VFR(0, 2), o0); o1 = ATT_MFMA(__builtin_bit_cast(bf16x8, pw2), ATT_VFR(1, 2), o1);
            o0 = ATT_MFMA(__builtin_bit_cast(bf16x8, pw3), ATT_VFR(0, 3), o0); o1 = ATT_MFMA(__builtin_bit_cast(bf16x8, pw3), ATT_VFR(1, 3), o1);
#undef ATT_VFR
        }
    }
#undef ATT_DMA
    { u32x4 zq[4]; load_zq(zq, T, qrow0, h, lane); unit_epilogue(lsum, o0, o1, qrow0, h, wid, lane, r32, hi, T, l3, zq); }
}

#define P_SBAR() __builtin_amdgcn_sched_barrier(0)
#define P_PIN(x) asm volatile("" : "+v"(x))
#define P_EX(v) __builtin_amdgcn_exp2f(v)
constexpr int PK_RING = 0, PV_RING = 49152, PSLOT = 8192;
template <int VAR> __device__ __forceinline__ void attn_run_p(int b, int h, int m4s, int n, const Tensors& T, char* lds) {
#define P_WB(N) do { if (VAR == 3) { asm volatile("s_waitcnt vmcnt(" #N ") lgkmcnt(0)" ::: "memory"); } else { ATT_WAIT_BAR(N); } } while (0)
    const unsigned lds0 = (unsigned)(uintptr_t)lds;
    const lds_cptr l3 = (lds_cptr)lds;
    const long rowbase = (long)b * SEQ;
    { const float* tg = T.tbg + h * TBG_STRIDE;
      for (int i = threadIdx.x; i < TB_FLOATS / 4; i += 512) ((ALAS f32x4*)(l3 + L_TB))[i] = ((const f32x4*)tg)[i]; }
#define P_DMAK(i) do { if (VAR != 2) glds16(kptr, (unsigned)__builtin_amdgcn_readfirstlane(kdst + (unsigned)(((i) % 6) * PSLOT))); kptr += 64 * 512; asm volatile("" : "+v"(kptr)); } while (0)
#define P_DMAV(i) do { if (VAR != 2) glds16(vptr, (unsigned)__builtin_amdgcn_readfirstlane(vdst + (unsigned)(((i) % 6) * PSLOT))); vptr += 64 * 512; asm volatile("" : "+v"(vptr)); } while (0)
    const bf16* kptr; const bf16* vptr; bf16x8 qr[4];
    { const int tid0 = threadIdx.x, lane = tid0 & 63, r32 = lane & 31, hi = lane >> 5; const int wid = __builtin_amdgcn_readfirstlane(tid0 >> 6), grp = wid >> 1, hf = wid & 1;
      const unsigned kdst = lds0 + PK_RING + wid * 1024, vdst = lds0 + PV_RING + wid * 1024;
      kptr = T.K + (rowbase + (long)(4 * m4s - 8) * 64 + 8 * wid + (lane >> 3)) * 512 + h * 64 + (((lane & 7) ^ ((lane >> 3) & 7)) * 8);
      vptr = T.V + (rowbase + (long)(4 * m4s - 8) * 64 + 8 * wid + (lane >> 3)) * 512 + h * 64 + ((((lane >> 2) & 1) ^ ((lane >> 4) & 1)) * 32) + (lane & 3) * 8;
      P_DMAK(0); P_DMAK(1); P_DMAK(2); P_DMAK(3); P_DMAK(4); P_DMAK(5); P_DMAV(0); P_DMAV(1);
      const bf16* Qw = T.Q + (rowbase + 64 * (4 * m4s + grp) + 32 * hf + r32) * 512 + h * 64 + hi * 8;
#pragma unroll
      for (int d0 = 0; d0 < 4; ++d0) qr[d0] = *reinterpret_cast<const bf16x8*>(Qw + d0 * 16); }
#pragma unroll 1
  for (int u = 0; u < n; ++u) {
    const int m4 = m4s + u;
    int tid = threadIdx.x; asm volatile("" : "+v"(tid));
    const int lane = tid & 63, r32 = lane & 31, hi = lane >> 5;
    const int wid = __builtin_amdgcn_readfirstlane(tid >> 6), grp = wid >> 1, hf = wid & 1;
    const int c = 4 * m4 + grp;
    const long qrow0 = rowbase + 64 * c + 32 * hf;
    const unsigned kdst = lds0 + PK_RING + wid * 1024, vdst = lds0 + PV_RING + wid * 1024;
    P_DMAV(2); P_DMAV(3);
#if ATT_PRIO
    if (wid >= 4) __builtin_amdgcn_s_setprio(ATT_PRIO);
#endif
    const int s = (4 - (r32 & 3)) & 3;
    const int e0 = TB_ORG - 32 * hf - r32 + 4 * hi - s;
    const lds_cptr tb0 = l3 + L_TB + s * (TB_COPY * 4) + e0 * 4;
    const lds_cptr kp0 = l3 + PK_RING + r32 * 128; const int ksw = r32 & 7;
#define P_KOFF(d0) ((((2 * (d0) + hi) ^ ksw) << 4))
    const lds_cptr vp0 = l3 + PV_RING + ((lane >> 4) & 1) * 32 + (lane & 3) * 8 + (4 * hi + ((lane & 15) >> 2)) * 128; const int vsw = ((lane >> 3) & 1) * 64;
    f32x16 o0 = f32x16{}, o1 = f32x16{}; float lsum = 0.f;
    f32x16 pA0, pA1, pB0, pB1; bf16x8 kf[8]; s16x4 vlo[4], vhi[4]; u32x4 pw0, pw1, pw2, pw3; lds_cptr vp_ = vp0;
    P_WB(1);
    { const lds_cptr kp = kp0 + (grp % 6) * PSLOT;
#pragma unroll
      for (int d0 = 0; d0 < 4; ++d0) { kf[2 * d0] = *(const ALAS bf16x8*)(kp + P_KOFF(d0)); kf[2 * d0 + 1] = *(const ALAS bf16x8*)(kp + P_KOFF(d0) + 4096); } }
#define P_PKW(P, B) cvtpk_s(P[B], P[(B) + 1])
#define P_PAF(k) __builtin_bit_cast(bf16x8, pw##k)
#define P_VFR(j) (bf16x8){vlo[j][0], vlo[j][1], vlo[j][2], vlo[j][3], vhi[j][0], vhi[j][1], vhi[j][2], vhi[j][3]}
#define P_VRD(j, i) do { if (VAR != 6) { vlo[j] = vtr(vp_ + (((((i) >> 2) * 64) ^ vsw) + ((i) & 3) * 2048)); vhi[j] = vtr(vp_ + (((((i) >> 2) * 64) ^ vsw) + ((i) & 3) * 2048 + 1024)); } } while (0)
#define P_KRD(G, j) do { if ((G) && VAR != 5) { kf[2 * (j)] = *(const ALAS bf16x8*)(kn_ + P_KOFF(j)); kf[2 * (j) + 1] = *(const ALAS bf16x8*)(kn_ + P_KOFF(j) + 4096); P_SBAR(); } } while (0)
#if !FAR_CONST
#define P_CFILL(X0, X1) do {} while (0)
#else
#define P_CFILL(X0, X1) do { _Pragma("unroll") for (int i_ = 0; i_ < 16; ++i_) { X0[i_] = cfar; X1[i_] = cfar; } P_PIN(X0); P_PIN(X1); P_SBAR(); } while (0)
#endif
#define P_TRD(G, X0, X1, g) do { if (((G) == 1) && VAR != 4) { const f32x4 ta_ = *(const ALAS f32x4*)(tn_ + 32 * (g)), tb_ = *(const ALAS f32x4*)(tn_ + 32 * ((g) + 4)); \
        X0[4 * (g)] = ta_[0]; X0[4 * (g) + 1] = ta_[1]; X0[4 * (g) + 2] = ta_[2]; X0[4 * (g) + 3] = ta_[3]; X1[4 * (g)] = tb_[0]; X1[4 * (g) + 1] = tb_[1]; X1[4 * (g) + 2] = tb_[2]; X1[4 * (g) + 3] = tb_[3]; P_SBAR(); } } while (0)
#define P_GAPA(MF, A0, A1, A2, A3, W0, W1, PW) do { MF; if (VAR != 7) { sacc += A0; sacc += A1; sacc += A2; sacc += A3; P_PIN(sacc); W0; W1; P_PIN(PW); } P_SBAR(); } while (0)
#define P_GAPB(MF, X, B) do { MF; if (VAR != 1) { X[B] = P_EX(X[B]); X[(B) + 1] = P_EX(X[(B) + 1]); X[(B) + 2] = P_EX(X[(B) + 2]); X[(B) + 3] = P_EX(X[(B) + 3]); } P_PIN(X); P_SBAR(); } while (0)
#define P_PHASE_A(C0, C1, CI0, CI1, P0, P1, k, HASP) do { P_SBAR(); \
    vp_ = vp0 + (((k) + 5 + grp) % 6) * PSLOT; float sacc = 0.f; \
    if (HASP) { sacc = P0[0] + P0[1]; } \
    if (HASP) P_GAPA(C0 = ATT_MFMA(kf[0], qr[0], CI0), P0[2], P0[3], P0[4], P0[5], pw0[0] = P_PKW(P0, 0), pw0[1] = P_PKW(P0, 2), pw0); else { C0 = ATT_MFMA(kf[0], qr[0], CI0); P_SBAR(); } \
    if (HASP) { P_GAPA(C1 = ATT_MFMA(kf[1], qr[0], CI1), P0[6], P0[7], P0[8], P0[9], pw0[2] = P_PKW(P0, 4), pw0[3] = P_PKW(P0, 6), pw0); } else { C1 = ATT_MFMA(kf[1], qr[0], CI1); P_SBAR(); } \
    if (HASP) { P_GAPA(C0 = ATT_MFMA(kf[2], qr[1], C0), P0[10], P0[11], P0[12], P0[13], pw1[0] = P_PKW(P0, 8), pw1[1] = P_PKW(P0, 10), pw1); } else { C0 = ATT_MFMA(kf[2], qr[1], C0); P_SBAR(); } \
    if (HASP) { P_GAPA(C1 = ATT_MFMA(kf[3], qr[1], C1), P0[14], P0[15], P1[0], P1[1], pw1[2] = P_PKW(P0, 12), pw1[3] = P_PKW(P0, 14), pw1); } else { C1 = ATT_MFMA(kf[3], qr[1], C1); P_SBAR(); } \
    if (HASP) { P_VRD(0, 0); P_SBAR(); P_GAPA(C0 = ATT_MFMA(kf[4], qr[2], C0), P1[2], P1[3], P1[4], P1[5], pw2[0] = P_PKW(P1, 0), pw2[1] = P_PKW(P1, 2), pw2); } else { C0 = ATT_MFMA(kf[4], qr[2], C0); P_SBAR(); } \
    if (HASP) { P_VRD(1, 4); P_SBAR(); P_GAPA(C1 = ATT_MFMA(kf[5], qr[2], C1), P1[6], P1[7], P1[8], P1[9], pw2[2] = P_PKW(P1, 4), pw2[3] = P_PKW(P1, 6), pw2); } else { C1 = ATT_MFMA(kf[5], qr[2], C1); P_SBAR(); } \
    if (HASP) { P_VRD(2, 1); P_SBAR(); P_GAPA(C0 = ATT_MFMA(kf[6], qr[3], C0), P1[10], P1[11], P1[12], P1[13], pw3[0] = P_PKW(P1, 8), pw3[1] = P_PKW(P1, 10), pw3); } else { C0 = ATT_MFMA(kf[6], qr[3], C0); P_SBAR(); } \
    if (HASP) { P_VRD(3, 5); P_SBAR(); P_GAPA(C1 = ATT_MFMA(kf[7], qr[3], C1), P1[14], P1[15], 0.f, 0.f, pw3[2] = P_PKW(P1, 12), pw3[3] = P_PKW(P1, 14), pw3); } else { C1 = ATT_MFMA(kf[7], qr[3], C1); P_SBAR(); } \
    lsum += sacc; } while (0)
#define P_PHASE_B(C0, C1, N0, N1, k, HASP, GK, GT) do { \
    const lds_cptr kn_ = kp0 + (((k) + 1 + grp) % 6) * PSLOT; const lds_cptr tn_ = tb0 - 256 * (7 - (k)); \
    if (HASP) { P_GAPB(o0 = ATT_MFMA(P_PAF(0), P_VFR(0), o0), C0, 0); P_VRD(0, 2); P_SBAR(); } else P_GAPB((void)0, C0, 0); \
    if (HASP) { P_GAPB(o1 = ATT_MFMA(P_PAF(0), P_VFR(1), o1), C0, 4); P_VRD(1, 6); P_SBAR(); } else P_GAPB((void)0, C0, 4); \
    P_KRD(GK, 0); if (HASP) { P_GAPB(o0 = ATT_MFMA(P_PAF(1), P_VFR(2), o0), C0, 8); P_VRD(2, 3); P_SBAR(); } else P_GAPB((void)0, C0, 8); \
    P_KRD(GK, 1); if (HASP) { P_GAPB(o1 = ATT_MFMA(P_PAF(1), P_VFR(3), o1), C0, 12); P_VRD(3, 7); P_SBAR(); } else P_GAPB((void)0, C0, 12); \
    P_KRD(GK, 2); if (HASP) P_GAPB(o0 = ATT_MFMA(P_PAF(2), P_VFR(0), o0), C1, 0); else P_GAPB((void)0, C1, 0); \
    P_KRD(GK, 3); if (HASP) P_GAPB(o1 = ATT_MFMA(P_PAF(2), P_VFR(1), o1), C1, 4); else P_GAPB((void)0, C1, 4); \
    P_TRD(GT, N0, N1, 0); if (HASP) P_GAPB(o0 = ATT_MFMA(P_PAF(3), P_VFR(2), o0), C1, 8); else P_GAPB((void)0, C1, 8); \
    P_TRD(GT, N0, N1, 1); if (HASP) P_GAPB(o1 = ATT_MFMA(P_PAF(3), P_VFR(3), o1), C1, 12); else P_GAPB((void)0, C1, 12); \
    P_TRD(GT, N0, N1, 2); P_TRD(GT, N0, N1, 3); if ((GT) == 2) P_CFILL(N0, N1); } while (0)
    { const lds_cptr tn_ = tb0 - 256 * 8; P_TRD(true, pA0, pA1, 0); P_TRD(true, pA0, pA1, 1); P_TRD(true, pA0, pA1, 2); P_TRD(true, pA0, pA1, 3); }
#if FAR_CONST
    float cfar = pA0[0]; P_PIN(cfar);
    P_PHASE_A(pA0, pA1, pA0, pA1, pB0, pB1, 0, false); P_DMAK(6); P_DMAV(4); P_PHASE_B(pA0, pA1, pB0, pB1, 0, false, true, 2); P_WB(2);
    P_PHASE_A(pB0, pB1, pB0, pB1, pA0, pA1, 1, true); P_DMAK(7); P_DMAV(5); P_PHASE_B(pB0, pB1, pA0, pA1, 1, true, true, 2); P_WB(2);
    P_PHASE_A(pA0, pA1, pA0, pA1, pB0, pB1, 2, true); P_DMAK(8); P_DMAV(6); P_PHASE_B(pA0, pA1, pB0, pB1, 2, true, true, 2); P_WB(2);
#pragma unroll 1
    for (int k = 3; k <= 7; k += 2) {
#elif ATT_DMA_EARLY
    P_DMAK(6); P_DMAV(4); P_PHASE_A(pA0, pA1, pA0, pA1, pB0, pB1, 0, false); P_PHASE_B(pA0, pA1, pB0, pB1, 0, false, true, true); P_WB(2);
#else
    P_PHASE_A(pA0, pA1, pA0, pA1, pB0, pB1, 0, false); P_DMAK(6); P_DMAV(4); P_PHASE_B(pA0, pA1, pB0, pB1, 0, false, true, true); P_WB(2);
#endif
#if !FAR_CONST
#pragma unroll 1
    for (int k = 1; k <= 7; k += 2) {
#endif
#if ATT_DMA_EARLY
        if (k + 6 <= 11) { P_DMAK(k + 6); } P_DMAV(k + 4); P_PHASE_A(pB0, pB1, pB0, pB1, pA0, pA1, k, true); P_PHASE_B(pB0, pB1, pA0, pA1, k, true, true, true);
#else
        P_PHASE_A(pB0, pB1, pB0, pB1, pA0, pA1, k, true);      if (k + 6 <= 11) { P_DMAK(k + 6); } P_DMAV(k + 4); P_PHASE_B(pB0, pB1, pA0, pA1, k, true, true, true);
#endif
        if (k + 6 <= 11) P_WB(2); else P_WB(1);
        const bool more = k + 1 < 8;
#if ATT_DMA_EARLY
        if (k + 7 <= 11) { P_DMAK(k + 7); } if (k + 5 <= 11) { P_DMAV(k + 5); } P_PHASE_A(pA0, pA1, pA0, pA1, pB0, pB1, k + 1, true); P_PHASE_B(pA0, pA1, pB0, pB1, k + 1, true, more, more);
#else
        P_PHASE_A(pA0, pA1, pA0, pA1, pB0, pB1, k + 1, true);  if (k + 7 <= 11) { P_DMAK(k + 7); } if (k + 5 <= 11) { P_DMAV(k + 5); } P_PHASE_B(pA0, pA1, pB0, pB1, k + 1, true, more, more);
#endif
        if (k + 7 <= 11) P_WB(2); else if (k + 5 <= 11) P_WB(1); else P_WB(0);
    }
    bf16x8 qn[4]; u32x4 zq[4];
    if (u + 1 < n) { kptr -= 8 * 64 * 512; vptr -= 8 * 64 * 512;
      P_DMAK(0); P_DMAK(1); P_DMAK(2); P_DMAK(3); P_DMAK(4); P_DMAK(5); P_DMAV(0); P_DMAV(1);
      const bf16* Qn = T.Q + (qrow0 + 256 + r32) * 512 + h * 64 + hi * 8;
#pragma unroll
      for (int d0 = 0; d0 < 4; ++d0) qn[d0] = *reinterpret_cast<const bf16x8*>(Qn + d0 * 16); }
    load_zq(zq, T, qrow0, h, lane);
    { vp_ = vp0 + ((8 + grp) % 6) * PSLOT;
      P_VRD(0, 0); P_VRD(1, 4); P_VRD(2, 1); P_VRD(3, 5);
      float sacc = 0.f;
#pragma unroll
      for (int r = 0; r < 16; ++r) sacc += pA0[r] + pA1[r];
      lsum += sacc;
      pw0 = (u32x4){P_PKW(pA0, 0), P_PKW(pA0, 2), P_PKW(pA0, 4), P_PKW(pA0, 6)}; pw1 = (u32x4){P_PKW(pA0, 8), P_PKW(pA0, 10), P_PKW(pA0, 12), P_PKW(pA0, 14)};
      pw2 = (u32x4){P_PKW(pA1, 0), P_PKW(pA1, 2), P_PKW(pA1, 4), P_PKW(pA1, 6)}; pw3 = (u32x4){P_PKW(pA1, 8), P_PKW(pA1, 10), P_PKW(pA1, 12), P_PKW(pA1, 14)};
      o0 = ATT_MFMA(P_PAF(0), P_VFR(0), o0); o1 = ATT_MFMA(P_PAF(0), P_VFR(1), o1); o0 = ATT_MFMA(P_PAF(1), P_VFR(2), o0); o1 = ATT_MFMA(P_PAF(1), P_VFR(3), o1);
      P_SBAR(); P_VRD(0, 2); P_VRD(1, 6); P_VRD(2, 3); P_VRD(3, 7); P_SBAR();
      o0 = ATT_MFMA(P_PAF(2), P_VFR(0), o0); o1 = ATT_MFMA(P_PAF(2), P_VFR(1), o1); o0 = ATT_MFMA(P_PAF(3), P_VFR(2), o0); o1 = ATT_MFMA(P_PAF(3), P_VFR(3), o1); }
    if (VAR == 8) { asm volatile("" :: "v"(o0), "v"(o1), "v"(lsum), "v"(zq[0]), "v"(zq[1]), "v"(zq[2]), "v"(zq[3])); asm volatile("s_waitcnt lgkmcnt(0)\n\ts_barrier" ::: "memory"); }
    else unit_epilogue(lsum, o0, o1, qrow0, h, wid, lane, r32, hi, T, l3, zq);
    if (u + 1 < n) {
#pragma unroll
      for (int d0 = 0; d0 < 4; ++d0) qr[d0] = qn[d0]; }
#if ATT_PRIO
    __builtin_amdgcn_s_setprio(0);
#endif
  }
#undef P_DMAK
#undef P_DMAV
}

constexpr int POOL_R = 8;
template <int W> __device__ __forceinline__ void pool_item(int g, long rb, const Tensors& T, int lane) {
    const long row0 = rb + POOL_R * (lane >> 4); const int t0 = (int)(row0 % SEQ);
    const int col = g * 128 + (lane & 15) * 8;
    const bf16* up = T.U + row0 * 512 + col;
    float S[8];
#pragma unroll
    for (int j = 0; j < 8; ++j) S[j] = 0.f;
#if POOL_REUSE
    constexpr int NI = W > 8 ? 8 : W;
    u32x4 fv[W > 8 ? 8 : 1];
    if (W > 8) {
#pragma unroll
        for (int a = 9; a <= W; ++a) { const bool ok = t0 - a >= 0; fv[W - a] = *(const u32x4*)(up - (long)(ok ? a : 0) * 512); const float mk = ok ? 1.0f : 0.0f;
#pragma unroll
            for (int j = 0; j < 4; ++j) { S[2 * j] += mk * bf_lo(fv[W - a][j]); S[2 * j + 1] += mk * bf_hi(fv[W - a][j]); } }
#pragma unroll
        for (int j = 0; j < 8; ++j) asm volatile("" : "+v"(S[j]));
        asm volatile("" ::: "memory");
    }
    u32x4 nv[POOL_R], zv[POOL_R], iv[NI];
#pragma unroll
    for (int r = 0; r < POOL_R; ++r) { nv[r] = *(const u32x4*)(up + (long)r * 512); zv[r] = SZ_LOAD((const u32x4*)(T.SZ + (size_t)(row0 + r) * 1024 + 512 + col)); }
#pragma unroll
    for (int a = 1; a <= NI; ++a) { const bool ok = t0 - a >= 0; iv[a - 1] = *(const u32x4*)(up - (long)(ok ? a : 0) * 512); const float mk = ok ? 1.0f : 0.0f;
#pragma unroll
        for (int j = 0; j < 4; ++j) { S[2 * j] += mk * bf_lo(iv[a - 1][j]); S[2 * j + 1] += mk * bf_hi(iv[a - 1][j]); } }
#pragma unroll
    for (int r = 0; r < POOL_R; ++r) {
        const int t = t0 + r; const float mk = (t - W >= 0) ? 1.0f : 0.0f;
        const float ic = (t + 1 < W) ? (FAST_RCP_POOL ? __builtin_amdgcn_rcpf((float)(t + 1)) : 1.0f / (float)(t + 1)) : 1.0f / (float)W;
        const u32x4 ovr = (W > 8) ? fv[r < 8 ? r : 0] : (r < W ? iv[(W - r - 1) < NI ? (W - r - 1) : 0] : nv[(r - W) >= 0 ? (r - W) : 0]);
        float nf[8];
#pragma unroll
        for (int j = 0; j < 4; ++j) { nf[2 * j] = bf_lo(nv[r][j]); nf[2 * j + 1] = bf_hi(nv[r][j]); S[2 * j] += nf[2 * j] - mk * bf_lo(ovr[j]); S[2 * j + 1] += nf[2 * j + 1] - mk * bf_hi(ovr[j]); }
        u32x4 o;
#pragma unroll
        for (int j = 0; j < 4; ++j) o[j] = cvtpk_s((S[2 * j] * ic - nf[2 * j]) * bf_lo(zv[r][j]), (S[2 * j + 1] * ic - nf[2 * j + 1]) * bf_hi(zv[r][j]));
        *(u32x4*)(T.Y + (size_t)(row0 + r) * 1024 + 512 + col) = o;
    }
#else
    if (W > 8) {
#pragma unroll
        for (int a = 9; a <= W; ++a) { const bool ok = t0 - a >= 0; const u32x4 v = *(const u32x4*)(up - (long)(ok ? a : 0) * 512); const float mk = ok ? 1.0f : 0.0f;
#pragma unroll
            for (int j = 0; j < 4; ++j) { S[2 * j] += mk * bf_lo(v[j]); S[2 * j + 1] += mk * bf_hi(v[j]); } }
#pragma unroll
        for (int j = 0; j < 8; ++j) asm volatile("" : "+v"(S[j]));
        asm volatile("" ::: "memory");
    }
    u32x4 nv[POOL_R], ov[POOL_R], zv[POOL_R];
#pragma unroll
    for (int r = 0; r < POOL_R; ++r) { nv[r] = *(const u32x4*)(up + (long)r * 512); zv[r] = SZ_LOAD((const u32x4*)(T.SZ + (size_t)(row0 + r) * 1024 + 512 + col));
        const bool ok = t0 + r - W >= 0; ov[r] = *(const u32x4*)(up + (long)(ok ? r - W : r) * 512); }
#pragma unroll
    for (int a = 1; a <= (W > 8 ? 8 : W); ++a) { const bool ok = t0 - a >= 0; const u32x4 v = *(const u32x4*)(up - (long)(ok ? a : 0) * 512); const float mk = ok ? 1.0f : 0.0f;
#pragma unroll
        for (int j = 0; j < 4; ++j) { S[2 * j] += mk * bf_lo(v[j]); S[2 * j + 1] += mk * bf_hi(v[j]); } }
#pragma unroll
    for (int r = 0; r < POOL_R; ++r) {
        const int t = t0 + r; const float mk = (t - W >= 0) ? 1.0f : 0.0f;
        const float ic = (t + 1 < W) ? (FAST_RCP_POOL ? __builtin_amdgcn_rcpf((float)(t + 1)) : 1.0f / (float)(t + 1)) : 1.0f / (float)W;
        float nf[8];
#pragma unroll
        for (int j = 0; j < 4; ++j) { nf[2 * j] = bf_lo(nv[r][j]); nf[2 * j + 1] = bf_hi(nv[r][j]); S[2 * j] += nf[2 * j] - mk * bf_lo(ov[r][j]); S[2 * j + 1] += nf[2 * j + 1] - mk * bf_hi(ov[r][j]); }
        u32x4 o;
#pragma unroll
        for (int j = 0; j < 4; ++j) o[j] = cvtpk_s((S[2 * j] * ic - nf[2 * j]) * bf_lo(zv[r][j]), (S[2 * j + 1] * ic - nf[2 * j + 1]) * bf_hi(zv[r][j]));
        *(u32x4*)(T.Y + (size_t)(row0 + r) * 1024 + 512 + col) = o;
    }
#endif
}
template <int W> __device__ __forceinline__ void pool_item64(int g, long rb, const Tensors& T, int lane) {
    const long row0 = rb + 16 * (lane >> 4); const int t0 = (int)(row0 % SEQ);
    const int col = g * 128 + (lane & 15) * 8;
    const bf16* up = T.U + row0 * 512 + col;
    const bf16* zp = T.SZ + (size_t)row0 * 1024 + 512 + col;
    bf16* yp = T.Y + (size_t)row0 * 1024 + 512 + col;
    constexpr int NI = W > 8 ? 8 : W;
    float S[8];
#pragma unroll
    for (int j = 0; j < 8; ++j) S[j] = 0.f;
    u32x4 fv[W > 8 ? 8 : 1], nv[16], zv[16], iv[NI];
    if (W > 8) {
#pragma unroll
        for (int a = 9; a <= W; ++a) { const bool ok = t0 - a >= 0; fv[W - a] = *(const u32x4*)(up - (long)(ok ? a : 0) * 512); }
    }
#pragma unroll
    for (int a = 1; a <= NI; ++a) { const bool ok = t0 - a >= 0; iv[a - 1] = *(const u32x4*)(up - (long)(ok ? a : 0) * 512); }
#pragma unroll
    for (int r = 0; r < 8; ++r) { nv[r] = *(const u32x4*)(up + (long)r * 512); zv[r] = SZ_LOAD((const u32x4*)(zp + (size_t)r * 1024)); }
    if (W <= 8) {
#pragma unroll
        for (int r = 8; r < 16; ++r) { nv[r] = *(const u32x4*)(up + (long)r * 512); zv[r] = SZ_LOAD((const u32x4*)(zp + (size_t)r * 1024)); } }
    __builtin_amdgcn_sched_barrier(0);
    if (W > 8) {
#pragma unroll
        for (int a = 9; a <= W; ++a) { const float mk = (t0 - a >= 0) ? 1.0f : 0.0f;
#pragma unroll
            for (int j = 0; j < 4; ++j) { S[2 * j] += mk * bf_lo(fv[W - a][j]); S[2 * j + 1] += mk * bf_hi(fv[W - a][j]); } }
        __builtin_amdgcn_sched_barrier(0);
    }
#pragma unroll
    for (int a = 1; a <= NI; ++a) { const float mk = (t0 - a >= 0) ? 1.0f : 0.0f;
#pragma unroll
        for (int j = 0; j < 4; ++j) { S[2 * j] += mk * bf_lo(iv[a - 1][j]); S[2 * j + 1] += mk * bf_hi(iv[a - 1][j]); } }
    __builtin_amdgcn_sched_barrier(0);
#pragma unroll
    for (int r = 0; r < 16; ++r) {
        if (W > 8 && r == POOL_N1_AT) {
#pragma unroll
            for (int q = 8; q < 16; ++q) nv[q] = *(const u32x4*)(up + (long)q * 512);
            __builtin_amdgcn_sched_barrier(0); }
        if (W > 8 && r == POOL_Z1_AT) {
#pragma unroll
            for (int q = 8; q < 16; ++q) zv[q] = SZ_LOAD((const u32x4*)(zp + (size_t)q * 1024));
            __builtin_amdgcn_sched_barrier(0); }
        const int t = t0 + r; const float mk = (t - W >= 0) ? 1.0f : 0.0f;
        const float ic = (t + 1 < W) ? (FAST_RCP_POOL ? __builtin_amdgcn_rcpf((float)(t + 1)) : 1.0f / (float)(t + 1)) : 1.0f / (float)W;
        const int a = W - r;
        const u32x4 ovr = (a >= 9) ? fv[(W > 8 && a >= 9) ? (W - a) : 0] : (a >= 1) ? iv[(a >= 1 && a <= NI) ? (a - 1) : 0] : nv[(a <= 0) ? (r - W) : 0];
        float nf[8];
#pragma unroll
        for (int j = 0; j < 4; ++j) { nf[2 * j] = bf_lo(nv[r][j]); nf[2 * j + 1] = bf_hi(nv[r][j]); S[2 * j] += nf[2 * j] - mk * bf_lo(ovr[j]); S[2 * j + 1] += nf[2 * j + 1] - mk * bf_hi(ovr[j]); }
        u32x4 o;
#pragma unroll
        for (int j = 0; j < 4; ++j) o[j] = cvtpk_s((S[2 * j] * ic - nf[2 * j]) * bf_lo(zv[r][j]), (S[2 * j + 1] * ic - nf[2 * j + 1]) * bf_hi(zv[r][j]));
        *(u32x4*)(yp + (size_t)r * 1024) = o;
        __builtin_amdgcn_sched_barrier(0);
    }
}
__device__ __forceinline__ void pool_dispatch64(int item, long slab_row0, const Tensors& T, int lane) {
    const int g = item & 3; const long rb = slab_row0 + (long)(item >> 2) * 64;
    if (g == 0) pool_item64<2>(g, rb, T, lane); else if (g == 1) pool_item64<4>(g, rb, T, lane); else if (g == 2) pool_item64<8>(g, rb, T, lane); else pool_item64<16>(g, rb, T, lane);
}
constexpr int NPOOL_ITEMS = 4 * (MROWS / (4 * POOL_R));
__device__ __forceinline__ void pool_dispatch(int item, const Tensors& T, int lane) {
    const int g = item & 3; const long rb = (long)(item >> 2) * (4 * POOL_R);
    if (g == 0) pool_item<2>(g, rb, T, lane); else if (g == 1) pool_item<4>(g, rb, T, lane); else if (g == 2) pool_item<8>(g, rb, T, lane); else pool_item<16>(g, rb, T, lane);
}
}

#define GAS __attribute__((address_space(1)))
#define LAS __attribute__((address_space(3)))
typedef unsigned short bf16;
typedef unsigned v4u __attribute__((ext_vector_type(4)));
typedef float f32x4 __attribute__((ext_vector_type(4)));
typedef short bf16x8 __attribute__((ext_vector_type(8)));
typedef GAS unsigned gu32;
typedef GAS unsigned long long gu64;
#define RLX_AGENT __ATOMIC_RELAXED, __HIP_MEMORY_SCOPE_AGENT
#define LDS_WAIT() asm volatile("s_waitcnt lgkmcnt(0)" ::: "memory")
#define VM_WAIT() asm volatile("s_waitcnt vmcnt(0)" ::: "memory")
__device__ __forceinline__ unsigned long long rt() { return __builtin_amdgcn_s_memrealtime(); }
__device__ __forceinline__ unsigned f2bf(float f) { unsigned u = __builtin_bit_cast(unsigned, f); return (u + 0x7fffu + ((u >> 16) & 1u)) >> 16; }
__device__ __forceinline__ unsigned pk2(float lo, float hi) { return f2bf(lo) | (f2bf(hi) << 16); }

typedef unsigned v2u_t __attribute__((ext_vector_type(2)));
__device__ __forceinline__ void st_sc1_16(void* p, v4u v) { asm volatile("global_store_dwordx4 %0, %1, off sc1\n\ts_nop 1" :: "v"(p), "v"(v) : "memory"); }
__device__ __forceinline__ void st_sc1_8(void* p, v2u_t v) { asm volatile("global_store_dwordx2 %0, %1, off sc1\n\ts_nop 1" :: "v"(p), "v"(v) : "memory"); }
__device__ __forceinline__ void st_sc1_4(void* p, float v) { asm volatile("global_store_dword %0, %1, off sc1\n\ts_nop 1" :: "v"(p), "v"(v) : "memory"); }

#define XB_TMO      128
#define XB_XCNT(j)  (256  + 64 * (j))
#define XB_XSUB(j)  (1280 + 64 * (j))
#define XB_XGEN(j)  (2304 + 64 * (j))
#define XB_TOP      3328
#define XB_TOPGEN   3392
#define XCD_BAR_WORDS 3456
#define XB_SPIN_CAP (1u << 18)

__device__ __forceinline__ unsigned xb_ld(unsigned* p)              { return __hip_atomic_load(p, __ATOMIC_RELAXED, __HIP_MEMORY_SCOPE_AGENT); }
__device__ __forceinline__ unsigned xb_add(unsigned* p, unsigned v) { return __hip_atomic_fetch_add(p, v, __ATOMIC_RELAXED, __HIP_MEMORY_SCOPE_AGENT); }
__device__ __forceinline__ unsigned xb_xcc_id() { return (unsigned)__builtin_amdgcn_s_getreg((3 << 11) | 20) & 0xFu; }
#if BAR_L2
__device__ __forceinline__ unsigned xb_add_l(unsigned* p, unsigned v) { return __hip_atomic_fetch_add(p, v, __ATOMIC_RELAXED, __HIP_MEMORY_SCOPE_WORKGROUP); }
__device__ __forceinline__ unsigned xb_ld_l(unsigned* p)              { return __hip_atomic_fetch_add(p, 0u, __ATOMIC_RELAXED, __HIP_MEMORY_SCOPE_WORKGROUP); }
#else
__device__ __forceinline__ unsigned xb_add_l(unsigned* p, unsigned v) { return xb_add(p, v); }
__device__ __forceinline__ unsigned xb_ld_l(unsigned* p)              { return xb_ld(p); }
#endif
#define XB_SPIN(cond, bar) do { unsigned _sp = 0; while (cond) { __builtin_amdgcn_s_sleep(1); \
    if ((++_sp & 255u) == 0u) { if (xb_ld(&(bar)[XB_TMO])) break; if (_sp > XB_SPIN_CAP) { atomicAdd(&(bar)[XB_TMO], 1u); break; } } } } while (0)

struct XcdBarrier {
    unsigned* bar; unsigned x, expect;
    volatile LAS unsigned* st;
};

__device__ __forceinline__ XcdBarrier xcd_barrier_post(unsigned* bar, volatile LAS unsigned* st, unsigned expect) {
    XcdBarrier b; b.bar = bar; b.x = xb_xcc_id(); b.st = st; b.expect = expect;
    if (threadIdx.x == 0) (void)xb_add(&bar[XB_XCNT(b.x)], 1u);
    return b;
}
__device__ __forceinline__ void xcd_barrier_complete(unsigned* bar, unsigned x, unsigned& nloc, unsigned& nx, unsigned G) {
    unsigned sum, cnt, mine, sp = 0u;
    for (;;) {
        sum = 0u; cnt = 0u; mine = 0u;
#pragma unroll
        for (unsigned j = 0; j < 16; ++j) { const unsigned c = xb_ld(&bar[XB_XCNT(j)]); sum += c; cnt += (c > 0u) ? 1u : 0u; mine = (j == x) ? c : mine; }
        if (sum == G) break;
        __builtin_amdgcn_s_sleep(1);
        if ((++sp & 255u) == 0u) { if (xb_ld(&bar[XB_TMO])) break; if (sp > XB_SPIN_CAP) { atomicAdd(&bar[XB_TMO], 1u); break; } }
    }
    nloc = mine > 0u ? mine : 1u; nx = cnt > 0u ? cnt : 1u;
}

__device__ __forceinline__ void xcd_barrier(const XcdBarrier& b, bool keep16 = false) {
    if (keep16) asm volatile("s_waitcnt vmcnt(16)" ::: "memory"); else
    asm volatile("s_waitcnt vmcnt(0)" ::: "memory");
    __syncthreads();
    if (threadIdx.x == 0) {
        unsigned* bar = b.bar;
        __builtin_amdgcn_s_waitcnt(0);
        unsigned nloc = b.st[0], nx = b.st[1];
        if (nloc == 0u) { xcd_barrier_complete(bar, b.x, nloc, nx, b.expect); b.st[0] = nloc; b.st[1] = nx; }
        const unsigned old = xb_add_l(&bar[XB_XSUB(b.x)], 1u);
        const unsigned gen = old / nloc;
        if (old + 1u == (gen + 1u) * nloc) {
            __builtin_amdgcn_fence(__ATOMIC_RELEASE, "agent");
            asm volatile("s_waitcnt vmcnt(0)" ::: "memory");
            const unsigned og = xb_add(&bar[XB_TOP], 1u);
            const unsigned tg = og / nx;
            if (og + 1u == (tg + 1u) * nx) xb_add(&bar[XB_TOPGEN], 1u);
            else XB_SPIN(xb_ld(&bar[XB_TOPGEN]) == tg, bar);
            __builtin_amdgcn_fence(__ATOMIC_ACQUIRE, "agent");
            xb_add_l(&bar[XB_XGEN(b.x)], 1u);
            asm volatile("s_waitcnt vmcnt(0)" ::: "memory");
        } else {
            XB_SPIN(xb_ld_l(&bar[XB_XGEN(b.x)]) == gen, bar);
            __builtin_amdgcn_fence(__ATOMIC_ACQUIRE, "agent");
            asm volatile("s_waitcnt vmcnt(0)" ::: "memory");
        }
    }
    __syncthreads();
}

__device__ __forceinline__ void xcd_barrier_sync(const XcdBarrier& b) {
    asm volatile("s_waitcnt vmcnt(0)" ::: "memory");
    __syncthreads();
    if (threadIdx.x == 0) {
        unsigned* bar = b.bar;
        __builtin_amdgcn_s_waitcnt(0);
        unsigned nloc = b.st[0], nx = b.st[1];
        if (nloc == 0u) { xcd_barrier_complete(bar, b.x, nloc, nx, b.expect); b.st[0] = nloc; b.st[1] = nx; }
        const unsigned old = xb_add_l(&bar[XB_XSUB(b.x)], 1u);
        const unsigned gen = old / nloc;
        if (old + 1u == (gen + 1u) * nloc) {
            asm volatile("s_waitcnt vmcnt(0)" ::: "memory");
            const unsigned og = xb_add(&bar[XB_TOP], 1u);
            const unsigned tg = og / nx;
            if (og + 1u == (tg + 1u) * nx) xb_add(&bar[XB_TOPGEN], 1u);
            else XB_SPIN(xb_ld(&bar[XB_TOPGEN]) == tg, bar);
            xb_add_l(&bar[XB_XGEN(b.x)], 1u);
            asm volatile("s_waitcnt vmcnt(0)" ::: "memory");
        } else {
            XB_SPIN(xb_ld_l(&bar[XB_XGEN(b.x)]) == gen, bar);
            asm volatile("s_waitcnt vmcnt(0)" ::: "memory");
        }
    }
    __syncthreads();
}

__device__ __forceinline__ void xcd_local_barrier(const XcdBarrier& b, unsigned* lb, unsigned round = 0u) {
    asm volatile("s_waitcnt vmcnt(0)" ::: "memory");
    __syncthreads();
    if (threadIdx.x == 0) {
        const unsigned nloc = b.st[0];
        const unsigned old = xb_add_l(&lb[64 * b.x], 1u);
        if (old + 1u == (round + 1u) * nloc) xb_add_l(&lb[1024 + 64 * b.x], 1u);
        else XB_SPIN(xb_ld_l(&lb[1024 + 64 * b.x]) == round, b.bar);
    }
    __syncthreads();
}

constexpr int NWAVES = 8;
#ifndef MK_N_LAUNCHES
#define MK_N_LAUNCHES 1
#endif
constexpr int N_LAUNCHES = MK_N_LAUNCHES;
constexpr int PER_PHASE = 5;
constexpr size_t MiB = 1u << 20;
constexpr size_t WS_CTL = 0, CTL_ZERO_BYTES = 128 * 1024;
constexpr size_t WS_MOD = 1 * MiB;
constexpr size_t WS_MODP = 1 * MiB + 256 * 1024;
constexpr size_t WS_TBG = 1 * MiB + 64 * 1024;
constexpr size_t WS_WIN = 2 * MiB, WS_WOUT = 8 * MiB;
constexpr size_t WS_XN = 16 * MiB;
constexpr size_t WS_Q = 80 * MiB, WS_K = 112 * MiB, WS_V = 144 * MiB, WS_U = 176 * MiB;
constexpr size_t WS_SZ = 208 * MiB, WS_Y = Y_ALIAS ? WS_XN : 272 * MiB, WS_END = 336 * MiB;
#define WSC1 (NOFENCE || P12_OVERLAP)
constexpr int CW_WCNT = 512;
constexpr int CW_PC = 8192;
constexpr int CW_GMASK = 256, CW_LB = 24576;
constexpr int CW_TMO = 0, CW_MODCNT = 64, CW_BAR = 4096;
constexpr int PHASE_BYTES = 155648;
constexpr int LDSCTL_OFF = PHASE_BYTES, LDS_BYTES = PHASE_BYTES + 512;
static_assert(att::L_END <= PHASE_BYTES && pg8::STAGE_BYTES + 8 * 3072 <= PHASE_BYTES && LDS_BYTES <= 163840, "LDS map");

struct Frame {
    LAS unsigned char* lds; volatile LAS unsigned* MISC; gu32* ctl;
    int tid, lane, wave, vcu, G;
    const float *x, *c, *norm_g, *w_ada, *b_ada, *w_in, *qg, *kg, *rel_bias, *w_pool, *pool_scale, *w_out; float* out;
    float *modf, *modp, *tbg; bf16 *Wt_in, *Wt_out, *XN, *Qb, *Kb, *Vb, *Ub, *SZ, *Y, *XB;
};
__device__ __forceinline__ float wave_sum(float v) {
#pragma unroll
    for (int o = 1; o < 64; o <<= 1) v += __shfl_xor(v, o);
    return v;
}
__device__ __forceinline__ float wave_max(float v) {
#pragma unroll
    for (int o = 1; o < 64; o <<= 1) v = fmaxf(v, __shfl_xor(v, o));
    return v;
}
__device__ __forceinline__ void p0_mod_item(Frame& F, int item) {
    const int cg = item % 48, kq = item / 48, n = cg * 64 + F.lane, k0 = kq * 256 + F.wave * 32;
    float wv[32];
#pragma unroll
    for (int i = 0; i < 32; ++i) wv[i] = __builtin_nontemporal_load(F.w_ada + (size_t)(k0 + i) * 3072 + n);
    float a0 = 0.f, a1 = 0.f, a2 = 0.f, a3 = 0.f;
#pragma unroll
    for (int i = 0; i < 32; ++i) { a0 += F.c[k0 + i] * wv[i]; a1 += F.c[1024 + k0 + i] * wv[i]; a2 += F.c[2048 + k0 + i] * wv[i]; a3 += F.c[3072 + k0 + i] * wv[i]; }
    LAS float* red = (LAS float*)F.lds;
    red[(F.wave * 4 + 0) * 64 + F.lane] = a0; red[(F.wave * 4 + 1) * 64 + F.lane] = a1; red[(F.wave * 4 + 2) * 64 + F.lane] = a2; red[(F.wave * 4 + 3) * 64 + F.lane] = a3;
    __syncthreads();
    if (F.tid < 256) { const int b = F.tid >> 6, col = F.tid & 63; float s = 0.f;
#pragma unroll
        for (int w = 0; w < 8; ++w) s += red[(w * 4 + b) * 64 + col];
        F.modp[(kq * 4 + b) * 3072 + cg * 64 + col] = s; }
    __syncthreads();
}
__device__ __forceinline__ void p0_transpose_item(const float* W, int K, int N, bf16* WT, LAS float* scr, int kb, int nb, int lane) {
    const int k0 = 64 * kb, n0 = 32 * nb;
#if TRANS_FULL
#pragma unroll
#else
#pragma unroll 8
#endif
    for (int i = 0; i < 32; ++i) { const int kk = 2 * i + (lane >> 5); scr[kk * 33 + (lane & 31)] = __builtin_nontemporal_load(W + (size_t)(k0 + kk) * N + n0 + (lane & 31)); }
    LDS_WAIT(); asm volatile("" ::: "memory");
    const int c = lane & 7;
#pragma unroll
    for (int j = 0; j < 4; ++j) { const int n = (lane >> 3) + 8 * j; const LAS float* s = scr + (8 * c) * 33 + n;
        v4u o; o.x = pk2(s[0 * 33], s[1 * 33]); o.y = pk2(s[2 * 33], s[3 * 33]); o.z = pk2(s[4 * 33], s[5 * 33]); o.w = pk2(s[6 * 33], s[7 * 33]);
        if (WSC1) st_sc1_16(WT + (size_t)(n0 + n) * K + k0 + 8 * c, o); else *(GAS v4u*)(WT + (size_t)(n0 + n) * K + k0 + 8 * c) = o; }
    LDS_WAIT(); asm volatile("" ::: "memory");
}
#if FOLD_V2
__device__ __forceinline__ void p0_fold_item(Frame& F, int item) {
    const int g = item >> 8, k0 = (item & 255) * 4, lane = F.lane;
    const float* wp = F.w_pool + (size_t)g * 128 * 128 + lane;
    const float* wi = F.w_in + (size_t)k0 * 3072 + 1536 + g * 128 + lane;
    LAS float* scr = (LAS float*)(F.lds + F.wave * 16384);
#pragma unroll
    for (int kk = 0; kk < 4; ++kk) { scr[kk * 128 + lane] = wi[(size_t)kk * 3072]; scr[kk * 128 + 64 + lane] = wi[(size_t)kk * 3072 + 64]; }
    LDS_WAIT(); asm volatile("" ::: "memory");
    float acc0[4], acc1[4];
#pragma unroll
    for (int kk = 0; kk < 4; ++kk) { acc0[kk] = 0.f; acc1[kk] = 0.f; }
    float bA0[32], bA1[32], bB0[32], bB1[32];
#define FOLD_LOAD(B0, B1, c) do { _Pragma("unroll") for (int ii = 0; ii < 32; ++ii) { B0[ii] = wp[(size_t)(32 * (c) + ii) * 128]; B1[ii] = wp[(size_t)(32 * (c) + ii) * 128 + 64]; } } while (0)
#define FOLD_MUL(B0, B1, c) do { _Pragma("unroll") for (int q = 0; q < 8; ++q) { _Pragma("unroll") for (int kk = 0; kk < 4; ++kk) { const f32x4 a4 = *(const LAS f32x4*)(scr + kk * 128 + 32 * (c) + 4 * q); \
        _Pragma("unroll") for (int e = 0; e < 4; ++e) { acc0[kk] += a4[e] * B0[4 * q + e]; acc1[kk] += a4[e] * B1[4 * q + e]; } } } } while (0)
    FOLD_LOAD(bA0, bA1, 0);
    FOLD_LOAD(bB0, bB1, 1); __builtin_amdgcn_sched_barrier(0);
    FOLD_MUL(bA0, bA1, 0); __builtin_amdgcn_sched_barrier(0);
    FOLD_LOAD(bA0, bA1, 2); __builtin_amdgcn_sched_barrier(0);
    FOLD_MUL(bB0, bB1, 1); __builtin_amdgcn_sched_barrier(0);
    FOLD_LOAD(bB0, bB1, 3); __builtin_amdgcn_sched_barrier(0);
    FOLD_MUL(bA0, bA1, 2); __builtin_amdgcn_sched_barrier(0);
    FOLD_MUL(bB0, bB1, 3);
#undef FOLD_LOAD
#undef FOLD_MUL
    LDS_WAIT(); asm volatile("" ::: "memory");
    const float s0 = F.pool_scale[g * 128 + lane], s1 = F.pool_scale[g * 128 + 64 + lane];
    typedef unsigned v2u __attribute__((ext_vector_type(2)));
    v2u o; o.x = pk2(acc0[0] * s0, acc0[1] * s0); o.y = pk2(acc0[2] * s0, acc0[3] * s0);
    if (WSC1) st_sc1_8(F.Wt_in + (size_t)(1536 + g * 128 + lane) * 1024 + k0, o); else *(GAS v2u*)(F.Wt_in + (size_t)(1536 + g * 128 + lane) * 1024 + k0) = o;
    o.x = pk2(acc1[0] * s1, acc1[1] * s1); o.y = pk2(acc1[2] * s1, acc1[3] * s1);
    if (WSC1) st_sc1_8(F.Wt_in + (size_t)(1536 + g * 128 + 64 + lane) * 1024 + k0, o); else *(GAS v2u*)(F.Wt_in + (size_t)(1536 + g * 128 + 64 + lane) * 1024 + k0) = o;
}
#else
__device__ __forceinline__ void p0_fold_item(Frame& F, int item) {
    const int g = item >> 8, k0 = (item & 255) * 4, lane = F.lane;
    const float* wp = F.w_pool + (size_t)g * 128 * 128;
    const float* wi = F.w_in + (size_t)k0 * 3072 + 1536 + g * 128;
    float acc0[4], acc1[4];
#pragma unroll
    for (int kk = 0; kk < 4; ++kk) { acc0[kk] = 0.f; acc1[kk] = 0.f; }
#pragma unroll 8
    for (int i = 0; i < 128; ++i) {
        const float w0 = wp[i * 128 + lane], w1 = wp[i * 128 + 64 + lane];
#pragma unroll
        for (int kk = 0; kk < 4; ++kk) { const float a = wi[(size_t)kk * 3072 + i]; acc0[kk] += a * w0; acc1[kk] += a * w1; }
    }
    const float s0 = F.pool_scale[g * 128 + lane], s1 = F.pool_scale[g * 128 + 64 + lane];
    typedef unsigned v2u __attribute__((ext_vector_type(2)));
    v2u o; o.x = pk2(acc0[0] * s0, acc0[1] * s0); o.y = pk2(acc0[2] * s0, acc0[3] * s0);
    if (WSC1) st_sc1_8(F.Wt_in + (size_t)(1536 + g * 128 + lane) * 1024 + k0, o); else *(GAS v2u*)(F.Wt_in + (size_t)(1536 + g * 128 + lane) * 1024 + k0) = o;
    o.x = pk2(acc1[0] * s1, acc1[1] * s1); o.y = pk2(acc1[2] * s1, acc1[3] * s1);
    if (WSC1) st_sc1_8(F.Wt_in + (size_t)(1536 + g * 128 + 64 + lane) * 1024 + k0, o); else *(GAS v2u*)(F.Wt_in + (size_t)(1536 + g * 128 + 64 + lane) * 1024 + k0) = o;
}
#endif
__device__ __forceinline__ void p0_table_item(Frame& F, int h) {
    const int lane = F.lane;
    const float gq = wave_max(fabsf(F.qg[lane])), gk = wave_max(fabsf(F.kg[lane]));
    float bm = -1e30f;
    for (int i = lane; i < 513; i += 64) bm = fmaxf(bm, F.rel_bias[h * 513 + i]);
    bm = wave_max(bm);
    const float M2 = (8.0f * gq * gk * 1.02f + bm) * LOG2E;
    float* T = F.tbg + h * att::TBG_STRIDE;
    for (int idx = lane; idx < att::TB_FLOATS; idx += 64) { const int s = idx / att::TB_COPY, i = idx % att::TB_COPY; int rel = i + s - att::TB_ORG; rel = rel < -256 ? -256 : (rel > 256 ? 256 : rel);
        const float tv = F.rel_bias[h * 513 + rel + 256] * LOG2E - M2; if (WSC1) st_sc1_4(T + idx, tv); else T[idx] = tv; }
    if (lane == 0) { const float tv = F.rel_bias[h * 513] * LOG2E - M2; if (WSC1) st_sc1_4(T + att::TB_FLOATS, tv); else T[att::TB_FLOATS] = tv; }
}
__device__ __forceinline__ void p0_fold_block(Frame& F, int t0 = -1, int tstride = 0) {
    LAS float* lwp = (LAS float*)F.lds;
    LAS float* lwi = (LAS float*)(F.lds + 65536) + F.wave * 256;
    const int lane = F.lane;
    if (t0 < 0) { t0 = F.vcu; tstride = F.G; }
    for (int t = t0; t < 256; t += tstride) {
        const int g = t & 3, k0 = 16 * (t >> 2) + 2 * F.wave;
        { const f32x4* src = (const f32x4*)(F.w_pool + (size_t)g * 128 * 128);
          f32x4 v[8];
#pragma unroll
          for (int j = 0; j < 8; ++j) v[j] = src[F.tid + 512 * j];
          const float* wi = F.w_in + (size_t)k0 * 3072 + 1536 + g * 128 + lane;
          const float a00 = wi[0], a01 = wi[64], a10 = wi[3072], a11 = wi[3072 + 64];
#pragma unroll
          for (int j = 0; j < 8; ++j) ((LAS f32x4*)lwp)[F.tid + 512 * j] = v[j];
          lwi[lane] = a00; lwi[64 + lane] = a01; lwi[128 + lane] = a10; lwi[192 + lane] = a11; }
        __syncthreads();
        float acc00 = 0.f, acc01 = 0.f, acc10 = 0.f, acc11 = 0.f;
#pragma unroll 4
        for (int q = 0; q < 32; ++q) {
            const f32x4 a0 = *(const LAS f32x4*)(lwi + 4 * q), a1 = *(const LAS f32x4*)(lwi + 128 + 4 * q);
#pragma unroll
            for (int e = 0; e < 4; ++e) { const float w0 = lwp[(4 * q + e) * 128 + lane], w1 = lwp[(4 * q + e) * 128 + 64 + lane];
                acc00 += a0[e] * w0; acc01 += a0[e] * w1; acc10 += a1[e] * w0; acc11 += a1[e] * w1; }
        }
        const float s0 = F.pool_scale[g * 128 + lane], s1 = F.pool_scale[g * 128 + 64 + lane];
        const unsigned o0 = pk2(acc00 * s0, acc10 * s0), o1 = pk2(acc01 * s1, acc11 * s1);
        if (WSC1) { st_sc1_4(F.Wt_in + (size_t)(1536 + g * 128 + lane) * 1024 + k0, __uint_as_float(o0)); st_sc1_4(F.Wt_in + (size_t)(1536 + g * 128 + 64 + lane) * 1024 + k0, __uint_as_float(o1)); }
        else { *(GAS unsigned*)(F.Wt_in + (size_t)(1536 + g * 128 + lane) * 1024 + k0) = o0; *(GAS unsigned*)(F.Wt_in + (size_t)(1536 + g * 128 + 64 + lane) * 1024 + k0) = o1; }
        __syncthreads();
    }
}
__device__ __forceinline__ void p0_prologue(Frame& F) {
    for (int item = F.vcu; item < 192; item += F.G) p0_mod_item(F, item);
}
__device__ __forceinline__ void p0_weights(Frame& F, int gw, int NGW) {
    LAS float* scr = (LAS float*)(F.lds + F.wave * 16384);
    constexpr int I_TIN = 16 * 80, I_TOUT = 16 * 32, I_FOLD = 1024, NITEMS = I_TIN + I_TOUT + I_FOLD + 8;
#if WEIGHT_BALANCE
    if (NGW == 2048) {
        if (gw & 1) { p0_fold_item(F, gw >> 1); return; }
        for (int t2 = gw >> 1; t2 < I_TIN + I_TOUT + 8; t2 += 1024) {
            if (t2 < 8) { p0_table_item(F, t2); continue; }
            const int t = t2 - 8;
            if (t < I_TIN) { const int kb = t / 80, nbp = t % 80, nb = nbp < 48 ? nbp : nbp + 16; p0_transpose_item(F.w_in, 1024, 3072, F.Wt_in, scr, kb, nb, F.lane); }
            else { const int r = t - I_TIN; p0_transpose_item(F.w_out, 1024, 1024, F.Wt_out, scr, r / 32, r % 32, F.lane); }
        }
        return;
    }
#endif
    for (int rnd = 0; rnd * NGW < NITEMS; ++rnd) {
        const int it = rnd * NGW + ((rnd & 1) ? gw : NGW - 1 - gw); if (it >= NITEMS) continue;
        if (it < I_FOLD) { if (!FOLD_BLOCK) for (int fr_ = 0; fr_ < FOLD_REP; ++fr_) p0_fold_item(F, it); continue; }
        if (it < I_FOLD + 8) { p0_table_item(F, it - I_FOLD); continue; }
        const int t = it - I_FOLD - 8;
        for (int tr_ = 0; tr_ < TRANS_REP; ++tr_)
        if (t < I_TIN) { const int kb = t / 80, nbp = t % 80, nb = nbp < 48 ? nbp : nbp + 16; p0_transpose_item(F.w_in, 1024, 3072, F.Wt_in, scr, kb, nb, F.lane); }
        else { const int r = t - I_TIN; p0_transpose_item(F.w_out, 1024, 1024, F.Wt_out, scr, r / 32, r % 32, F.lane); }
    }
}
__device__ __forceinline__ float mod_at(const Frame& F, int b, int col) {
    return ((F.modp[(0 * 4 + b) * 3072 + col] + F.modp[(1 * 4 + b) * 3072 + col]) + (F.modp[(2 * 4 + b) * 3072 + col] + F.modp[(3 * 4 + b) * 3072 + col])) + F.b_ada[col];
}
__device__ __forceinline__ f32x4 mod_at4(const Frame& F, int b, int col) {
    const f32x4 p0 = *(const f32x4*)(F.modp + (0 * 4 + b) * 3072 + col), p1 = *(const f32x4*)(F.modp + (1 * 4 + b) * 3072 + col), p2 = *(const f32x4*)(F.modp + (2 * 4 + b) * 3072 + col), p3 = *(const f32x4*)(F.modp + (3 * 4 + b) * 3072 + col);
    return ((p0 + p1) + (p2 + p3)) + *(const f32x4*)(F.b_ada + col);
}
__device__ __forceinline__ void p1_preload(const Frame& F, int gw, int NGW, f32x4 (&pre)[4][4]) {
    const int rpw = (((MROWS + NGW - 1) / NGW) + 3) & ~3, m0 = gw * rpw;
    const int mf = (P1_INTERLEAVE && NGW == 2048) ? (gw >> 8) * 4096 + (((gw & 255) + P1_ROT * (gw >> 8)) & 1023) * 4 : m0;
    if (m0 + 4 <= MROWS) {
#pragma unroll
        for (int r = 0; r < 4; ++r) { const float* xr = F.x + (size_t)(mf + r) * DMODEL + 4 * F.lane;
#pragma unroll
            for (int j = 0; j < 4; ++j) pre[r][j] = __builtin_nontemporal_load((const f32x4*)(xr + 256 * j)); }
        __builtin_amdgcn_sched_barrier(0);
    }
}
__device__ __forceinline__ void p1_xn(Frame& F, int gw, int NGW, int b0, int nb, const f32x4 (&pre)[4][4], bool has_pre, bool nostore = false) {
    for (int i = gw * 64 + F.lane; i < nb * 3072; i += NGW * 64) { const float mv = mod_at(F, b0 + i / 3072, i % 3072); if (WSC1) st_sc1_4(F.modf + b0 * 3072 + i, mv); else F.modf[b0 * 3072 + i] = mv; }
    const int rows = nb * SEQ, rpw = (((rows + NGW - 1) / NGW) + 3) & ~3;
    const int m0 = b0 * SEQ + gw * rpw, m1 = (m0 + rpw < (b0 + nb) * SEQ) ? m0 + rpw : (b0 + nb) * SEQ;
    f32x4 gs[4], sh[4]; int curb = -1;
    const bool il = P1_INTERLEAVE && NGW == 2048 && b0 == 0 && nb == BATCH;
    const int slab0 = (gw >> 8) * 4096, lw4 = (gw & 255) * 4;
#if P1_DYN
    if (il && !has_pre && !nostore) {
        { const int b = slab0 / SEQ;
#pragma unroll
          for (int j = 0; j < 4; ++j) { const int col = 4 * F.lane + 256 * j;
              const f32x4 g4 = *(const f32x4*)(F.norm_g + col), sc4 = mod_at4(F, b, 1024 + col);
              sh[j] = mod_at4(F, b, col); gs[j] = g4 * (sc4 + 1.0f); } }
        unsigned* cnt = (unsigned*)(F.ctl + 1024 + 64 * (gw >> 8));
        auto grab = [&]() -> int { unsigned v = 0u; if (F.lane == 0) v = __hip_atomic_fetch_add(cnt, 1u, __ATOMIC_RELAXED, __HIP_MEMORY_SCOPE_AGENT); return __builtin_amdgcn_readfirstlane((int)v); };
        int q = grab();
        while (q < 1024) {
            const int m = slab0 + 4 * q;
            f32x4 v[4][4]; float s2[4];
#pragma unroll
            for (int r = 0; r < 4; ++r) { const GAS f32x4* xr = (const GAS f32x4*)(F.x + (size_t)(m + r) * DMODEL) + F.lane;
#pragma unroll
                for (int j = 0; j < 4; ++j) v[r][j] = __builtin_nontemporal_load(xr + 64 * j); }
            const int qn = grab();
#pragma unroll
            for (int r = 0; r < 4; ++r) { s2[r] = 0.f;
#pragma unroll
                for (int j = 0; j < 4; ++j) s2[r] += (v[r][j].x * v[r][j].x + v[r][j].y * v[r][j].y) + (v[r][j].z * v[r][j].z + v[r][j].w * v[r][j].w); }
#pragma unroll
            for (int o = 1; o < 64; o <<= 1) {
#pragma unroll
                for (int r = 0; r < 4; ++r) s2[r] += __shfl_xor(s2[r], o); }
#pragma unroll
            for (int r = 0; r < 4; ++r) { const float rstd = FAST_RCP ? __builtin_amdgcn_rsqf(s2[r] * (1.0f / DMODEL) + RMS_EPS) : 1.0f / sqrtf(s2[r] * (1.0f / DMODEL) + RMS_EPS);
                GAS unsigned long long* o8 = (GAS unsigned long long*)(F.XN + (size_t)(m + r) * DMODEL) + F.lane;
#pragma unroll
                for (int j = 0; j < 4; ++j) { const f32x4 y = v[r][j] * rstd * gs[j] + sh[j];
                    o8[64 * j] = (unsigned long long)pk2(y.x, y.y) | ((unsigned long long)pk2(y.z, y.w) << 32); } }
            q = qn;
        }
        return;
    }
#endif
#if P1_PIPE
    if (il && !has_pre) {
        { const int b = slab0 / SEQ;
#pragma unroll
          for (int j = 0; j < 4; ++j) { const int col = 4 * F.lane + 256 * j;
              const f32x4 g4 = *(const f32x4*)(F.norm_g + col), sc4 = mod_at4(F, b, 1024 + col);
              sh[j] = mod_at4(F, b, col); gs[j] = g4 * (sc4 + 1.0f); } }
        auto load4 = [&](f32x4 (&v)[4][4], int m) {
#pragma unroll
            for (int r = 0; r < 4; ++r) { const GAS f32x4* xr = (const GAS f32x4*)(F.x + (size_t)(m + r) * DMODEL) + F.lane;
#pragma unroll
                for (int j = 0; j < 4; ++j) v[r][j] = __builtin_nontemporal_load(xr + 64 * j); } };
        auto proc4 = [&](const f32x4 (&v)[4][4], int m) {
            float s2[4];
#pragma unroll
            for (int r = 0; r < 4; ++r) { s2[r] = 0.f;
#pragma unroll
                for (int j = 0; j < 4; ++j) s2[r] += (v[r][j].x * v[r][j].x + v[r][j].y * v[r][j].y) + (v[r][j].z * v[r][j].z + v[r][j].w * v[r][j].w); }
#pragma unroll
            for (int o = 1; o < 64; o <<= 1) {
#pragma unroll
                for (int r = 0; r < 4; ++r) s2[r] += __shfl_xor(s2[r], o); }
#pragma unroll
            for (int r = 0; r < 4; ++r) { const float rstd = FAST_RCP ? __builtin_amdgcn_rsqf(s2[r] * (1.0f / DMODEL) + RMS_EPS) : 1.0f / sqrtf(s2[r] * (1.0f / DMODEL) + RMS_EPS);
                GAS unsigned long long* o8 = (GAS unsigned long long*)(F.XN + (size_t)(m + r) * DMODEL) + F.lane;
#pragma unroll
                for (int j = 0; j < 4; ++j) { const f32x4 y = v[r][j] * rstd * gs[j] + sh[j];
                    o8[64 * j] = (unsigned long long)pk2(y.x, y.y) | ((unsigned long long)pk2(y.z, y.w) << 32); } } };
        const int q0 = slab0 + lw4, q1 = q0 + 1024, q2 = q0 + 2048, q3 = q0 + 3072;
        f32x4 va[4][4], vb[4][4];
#if P1_PIPE == 2
        load4(va, q0); load4(vb, q1); __builtin_amdgcn_sched_barrier(0);
        proc4(va, q0); proc4(vb, q1); __builtin_amdgcn_sched_barrier(0);
        load4(va, q2); load4(vb, q3); __builtin_amdgcn_sched_barrier(0);
        proc4(va, q2); proc4(vb, q3);
#else
        load4(va, q0); load4(vb, q1); __builtin_amdgcn_sched_barrier(0);
        proc4(va, q0); __builtin_amdgcn_sched_barrier(0); load4(va, q2); __builtin_amdgcn_sched_barrier(0);
        proc4(vb, q1); __builtin_amdgcn_sched_barrier(0); load4(vb, q3); __builtin_amdgcn_sched_barrier(0);
        proc4(va, q2); __builtin_amdgcn_sched_barrier(0);
        proc4(vb, q3);
#endif
        return;
    }
#endif
    for (int mi = m0; mi < m1; mi += P1_RPI) {
        const int m = il ? slab0 + (((((mi - m0) / P1_RPI) * 256 + (lw4 >> 2) + P1_ROT * (gw >> 8)) & (4096 / P1_RPI - 1)) * P1_RPI) : mi;
        const int b = m / SEQ;
        if (b != curb) { curb = b;
#pragma unroll
            for (int j = 0; j < 4; ++j) { const int col = 4 * F.lane + 256 * j;
                const f32x4 g4 = *(const f32x4*)(F.norm_g + col), sc4 = mod_at4(F, b, 1024 + col);
                sh[j] = mod_at4(F, b, col); gs[j] = g4 * (sc4 + 1.0f); } }
        f32x4 v[P1_RPI][4]; float s2[P1_RPI];
        if (has_pre && mi == m0) {
#pragma unroll
            for (int r = 0; r < P1_RPI; ++r)
#pragma unroll
                for (int j = 0; j < 4; ++j) v[r][j] = pre[r][j];
        } else {
#ifdef P1_POL
#pragma unroll
        for (int r = 0; r < P1_RPI; ++r) { const float* xr = F.x + (size_t)(m + r) * DMODEL + 4 * F.lane;
#pragma unroll
            for (int j = 0; j < 4; ++j) asm volatile("global_load_dwordx4 %0, %1, off " P1_POL : "=v"(v[r][j]) : "v"(xr + 256 * j) : "memory"); }
        asm volatile("s_waitcnt vmcnt(0)" ::: "memory");
#pragma unroll
        for (int r = 0; r < P1_RPI; ++r)
#pragma unroll
            for (int j = 0; j < 4; ++j) asm volatile("" : "+v"(v[r][j]));
#else
#pragma unroll
        for (int r = 0; r < P1_RPI; ++r) { const GAS f32x4* xr = (const GAS f32x4*)(F.x + (size_t)(m + r) * DMODEL) + F.lane;
#pragma unroll
            for (int j = 0; j < 4; ++j) v[r][j] = P1_PLAIN_LOADS ? xr[64 * j] : __builtin_nontemporal_load(xr + 64 * j); }
#endif
        }
#pragma unroll
        for (int r = 0; r < P1_RPI; ++r) { s2[r] = 0.f;
#pragma unroll
            for (int j = 0; j < 4; ++j) s2[r] += (v[r][j].x * v[r][j].x + v[r][j].y * v[r][j].y) + (v[r][j].z * v[r][j].z + v[r][j].w * v[r][j].w); }
#pragma unroll
        for (int o = 1; o < 64; o <<= 1) {
#pragma unroll
            for (int r = 0; r < P1_RPI; ++r) s2[r] += __shfl_xor(s2[r], o); }
#pragma unroll
        for (int r = 0; r < P1_RPI; ++r) { const float rstd = FAST_RCP ? __builtin_amdgcn_rsqf(s2[r] * (1.0f / DMODEL) + RMS_EPS) : 1.0f / sqrtf(s2[r] * (1.0f / DMODEL) + RMS_EPS);
            GAS unsigned long long* o8 = (GAS unsigned long long*)(F.XN + (size_t)(m + r) * DMODEL) + F.lane;
#pragma unroll
            for (int j = 0; j < 4; ++j) { const f32x4 y = v[r][j] * rstd * gs[j] + sh[j];
                if (nostore) { asm volatile("" :: "v"(y)); continue; }
#if XB_RESID
                __builtin_nontemporal_store((unsigned long long)att::cvtpk_s(v[r][j].x, v[r][j].y) | ((unsigned long long)att::cvtpk_s(v[r][j].z, v[r][j].w) << 32), (unsigned long long*)((GAS unsigned long long*)(F.XB + (size_t)(m + r) * DMODEL) + F.lane + 64 * j));
#endif
                o8[64 * j] = P1_HWCVT ? ((unsigned long long)att::cvtpk_s(y.x, y.y) | ((unsigned long long)att::cvtpk_s(y.z, y.w) << 32)) : ((unsigned long long)pk2(y.x, y.y) | ((unsigned long long)pk2(y.z, y.w) << 32)); } }
    }
}

__device__ __forceinline__ void p1_rows_tm(Frame& F, int x, int lw, unsigned* tcnt) {
    const int slab0 = x * 4096, b = slab0 / SEQ;
    f32x4 gs[4], sh[4];
#pragma unroll
    for (int j = 0; j < 4; ++j) { const int col = 4 * F.lane + 256 * j;
        const f32x4 g4 = *(const f32x4*)(F.norm_g + col), sc4 = mod_at4(F, b, 1024 + col);
        sh[j] = mod_at4(F, b, col); gs[j] = g4 * (sc4 + 1.0f); }
#pragma unroll 1
    for (int it2 = 0; it2 < 8; it2 += TM_Q) {
      f32x4 vv[TM_Q][4][4];
#pragma unroll
      for (int q = 0; q < TM_Q; ++q) { const int mq = slab0 + (it2 + q) * 512 + lw * 4;
#pragma unroll
        for (int r = 0; r < 4; ++r) { const GAS f32x4* xr = (const GAS f32x4*)(F.x + (size_t)(mq + r) * DMODEL) + F.lane;
#pragma unroll
            for (int j = 0; j < 4; ++j) vv[q][r][j] = __builtin_nontemporal_load(xr + 64 * j); } }
#pragma unroll
      for (int q = 0; q < TM_Q; ++q) {
        const int it = it2 + q;
        const int m = slab0 + it * 512 + lw * 4;
        f32x4 (&v)[4][4] = vv[q]; float s2[4];
#pragma unroll
        for (int r = 0; r < 4; ++r) { s2[r] = 0.f;
#pragma unroll
            for (int j = 0; j < 4; ++j) s2[r] += (v[r][j].x * v[r][j].x + v[r][j].y * v[r][j].y) + (v[r][j].z * v[r][j].z + v[r][j].w * v[r][j].w); }
#pragma unroll
        for (int o = 1; o < 64; o <<= 1) {
#pragma unroll
            for (int r = 0; r < 4; ++r) s2[r] += __shfl_xor(s2[r], o); }
#pragma unroll
        for (int r = 0; r < 4; ++r) { const float rstd = FAST_RCP ? __builtin_amdgcn_rsqf(s2[r] * (1.0f / DMODEL) + RMS_EPS) : 1.0f / sqrtf(s2[r] * (1.0f / DMODEL) + RMS_EPS);
            GAS unsigned long long* o8 = (GAS unsigned long long*)(F.XN + (size_t)(m + r) * DMODEL) + F.lane;
#pragma unroll
            for (int j = 0; j < 4; ++j) { const f32x4 y = v[r][j] * rstd * gs[j] + sh[j];
                o8[64 * j] = (unsigned long long)pk2(y.x, y.y) | ((unsigned long long)pk2(y.z, y.w) << 32); } }
        asm volatile("s_waitcnt vmcnt(0)" ::: "memory");
        if (F.lane == 0) (void)__hip_atomic_fetch_add(tcnt + 64 * (16 * x + 2 * it + (lw >> 6)), 1u, __ATOMIC_RELAXED, __HIP_MEMORY_SCOPE_AGENT);
      }
    }
}
struct Args { const float* in[12]; float* out; unsigned char* ws; int ph_lo, ph_hi, li, pad; unsigned char* xn; unsigned char* tn[6]; };
__global__ void __launch_bounds__(NWAVES * 64, 2) mk_fwd(Args args) {
    extern __shared__ __attribute__((aligned(16))) unsigned char lds[];
    Frame F;
    F.lds = (LAS unsigned char*)lds;
    F.MISC = (volatile LAS unsigned*)(F.lds + LDSCTL_OFF);
    F.tid = threadIdx.x; F.lane = F.tid & 63; F.wave = __builtin_amdgcn_readfirstlane(F.tid >> 6);
    F.G = gridDim.x; { const int bx = blockIdx.x; F.vcu = (F.G % 8 == 0) ? (bx % 8) * (F.G / 8) + bx / 8 : bx; }
    unsigned char* ws = args.ws;
    F.ctl = (gu32*)(ws + WS_CTL);
    F.x = args.in[0]; F.c = args.in[1]; F.norm_g = args.in[2]; F.w_ada = args.in[3]; F.b_ada = args.in[4]; F.w_in = args.in[5];
    F.qg = args.in[6]; F.kg = args.in[7]; F.rel_bias = args.in[8]; F.w_pool = args.in[9]; F.pool_scale = args.in[10]; F.w_out = args.in[11]; F.out = args.out;
    F.modf = (float*)(ws + WS_MOD); F.modp = (float*)(ws + WS_MODP); F.tbg = (float*)(ws + WS_TBG);
    F.Wt_in = (bf16*)(ws + WS_WIN); F.Wt_out = (bf16*)(ws + WS_WOUT); F.XN = (bf16*)(args.xn);
#if QKVU_IN_OUT
    { unsigned char* ob = (unsigned char*)args.out; F.Qb = (bf16*)(ob); F.Kb = (bf16*)(ob + 32 * MiB); F.Vb = (bf16*)(ob + 64 * MiB); F.Ub = (bf16*)(ob + 96 * MiB); }
#else
    F.Qb = (bf16*)args.tn[0]; F.Kb = (bf16*)args.tn[1]; F.Vb = (bf16*)args.tn[2]; F.Ub = (bf16*)args.tn[3];
#endif
    F.SZ = (bf16*)args.tn[4]; F.Y = (bf16*)args.tn[5]; F.XB = (bf16*)(ws + WS_XN);
    for (int u = F.tid; u < (LDS_BYTES - LDSCTL_OFF) / 4; u += NWAVES * 64) ((LAS unsigned*)(F.lds + LDSCTL_OFF))[u] = 0u;
    __syncthreads();
#if SPLIT34
#define PSTASH(k, p) do { const unsigned long long v_ = (unsigned long long)(uintptr_t)(p); F.MISC[64 + 2 * (k)] = (unsigned)v_; F.MISC[65 + 2 * (k)] = (unsigned)(v_ >> 32); } while (0)
#define PLOAD(T, k) ((T)(uintptr_t)(((unsigned long long)(unsigned)__builtin_amdgcn_readfirstlane((int)F.MISC[65 + 2 * (k)]) << 32) | (unsigned)__builtin_amdgcn_readfirstlane((int)F.MISC[64 + 2 * (k)])))
    if (F.tid == 0) { PSTASH(0, F.Qb); PSTASH(1, F.Kb); PSTASH(2, F.Vb); PSTASH(3, F.Ub); PSTASH(4, F.SZ); PSTASH(5, F.Y); PSTASH(6, ws + WS_TBG);
                      PSTASH(7, ws + WS_WOUT); PSTASH(8, args.in[0]); PSTASH(9, args.out); PSTASH(10, ws + WS_MOD); }
    __syncthreads();
#endif
    XcdBarrier bar; bar.bar = (unsigned*)(F.ctl + CW_BAR); bar.x = 0; bar.st = nullptr; bar.expect = 0;
    if (N_LAUNCHES != PER_PHASE) bar = xcd_barrier_post((unsigned*)(F.ctl + CW_BAR), F.MISC + 8, (unsigned)F.G);
#if LOCAL_P34
    if (N_LAUNCHES != PER_PHASE && F.tid == 0) (void)__hip_atomic_fetch_or((unsigned*)(F.ctl + CW_GMASK + (blockIdx.x & 7)), 1u << bar.x, __ATOMIC_RELAXED, __HIP_MEMORY_SCOPE_AGENT);
#endif
#define GRID_BAR() do { if (N_LAUNCHES != PER_PHASE) { for (int rb_ = 0; rb_ < REP_BAR; ++rb_) xcd_barrier(bar); } } while (0)
#if NOFENCE
#define SEAM_BAR() do { if (N_LAUNCHES != PER_PHASE) { bool ok_ = (F.G == 256); unsigned un_ = 0u; \
        for (int k_ = 0; k_ < 8; ++k_) { const unsigned m_ = xb_ld((unsigned*)(F.ctl + CW_GMASK + k_)); ok_ = ok_ && m_ != 0u && (m_ & (m_ - 1u)) == 0u; un_ |= m_; } \
        ok_ = ok_ && __builtin_popcount(un_) == 8; if (ok_) xcd_barrier_sync(bar); else xcd_barrier(bar); } } while (0)
#else
#define SEAM_BAR() GRID_BAR()
#endif
#if PROBE_STAMP >= 0
#define STAMP(j) do { if (blockIdx.x == PROBE_BLK && F.tid == 0) { const unsigned long long t_ = __builtin_amdgcn_s_memrealtime(); F.MISC[16 + 2 * (j)] = (unsigned)t_; F.MISC[17 + 2 * (j)] = (unsigned)(t_ >> 32); } } while (0)
#else
#define STAMP(j) do {} while (0)
#endif
    STAMP(0);
#if QUARTERS
    if (N_LAUNCHES == 1 && (F.G % 32) == 0) {
        const int Gq = F.G / 4, bx = blockIdx.x, q = (bx & 7) >> 1, lc = (bx & 1) * (Gq / 2) + (bx >> 3);
        const int gwl = lc * NWAVES + F.wave, ngwl = Gq * NWAVES;
        XcdBarrier qbar = xcd_barrier_post((unsigned*)(F.ctl + CW_BAR) + (1 + q) * XCD_BAR_WORDS, F.MISC + 10, (unsigned)Gq);
        p0_prologue(F);
        xcd_barrier(bar);
        if (q == 0) p1_xn(F, gwl, ngwl, 0, 1);
        else p0_weights(F, ((q - 1) * Gq + lc) * NWAVES + F.wave, 3 * Gq * NWAVES);
        xcd_barrier(bar);
        if (q >= 2) { const unsigned long long t0_ = __builtin_amdgcn_s_memrealtime(), want_ = (unsigned long long)(q - 1) * STAG_TICKS; while (__builtin_amdgcn_s_memrealtime() - t0_ < want_) __builtin_amdgcn_s_sleep(16); }
        if (q > 0) p1_xn(F, gwl, ngwl, q, 1);
        xcd_barrier(qbar);
        const size_t rowoff = (size_t)q * SEQ;
        {
            pg8::Gemm g{F.XN + rowoff * DMODEL, F.Wt_in, SEQ, NPROJ, DMODEL}; pg8::HalvesOrder S; S.init(SEQ, NPROJ, Gq, lc);
            pg8::EpiProj E{F.Qb + rowoff * 512, F.Kb + rowoff * 512, F.Vb + rowoff * 512, F.Ub + rowoff * 512, F.SZ + rowoff * 1024, F.qg, F.kg, QSCALE, F.lds + pg8::STAGE_BYTES};
            pg8::gemm_phase<pg8::EpiProj, pg8::HalvesOrder, PG8_ALIGN, PG8_SP2>(F.lds, g, S, E);
        }
        xcd_barrier(qbar);
        {
            const att::Tensors AT{(const att::bf16*)F.Qb, (const att::bf16*)F.Kb, (const att::bf16*)F.Vb, (const att::bf16*)F.Ub, (const att::bf16*)F.SZ, (att::bf16*)F.Y, F.tbg};
            const int nuq = att::NUNITS / 4, upc = (nuq + Gq - 1) / Gq;
            const int i0 = q * nuq + lc * upc, i1 = (lc * upc + upc < nuq) ? i0 + upc : q * nuq + nuq;
            int idx = i0;
            while (idx < i1) {
                if ((idx & 31) < 2) { att::attn_unit(idx >> 8, (idx >> 5) & 7, idx & 31, AT, (char*)lds); ++idx; continue; }
                int e = idx + 1; while (e < i1 && (e & 31) != 0) ++e;
                att::attn_run_p<0>(idx >> 8, (idx >> 5) & 7, idx & 31, e - idx, AT, (char*)lds); idx = e;
            }
            const int npq = att::NPOOL_ITEMS / 4;
            for (int it = gwl; it < npq; it += ngwl) att::pool_dispatch(q * npq + it, AT, F.lane);
        }
        xcd_barrier(qbar);
        {
            pg8::Gemm g{F.Y + rowoff * DMODEL, F.Wt_out, SEQ, DMODEL, DMODEL}; pg8::HalvesOrder S; S.init(SEQ, DMODEL, Gq, lc);
            pg8::EpiOut E{F.x + rowoff * DMODEL, F.out + rowoff * DMODEL, F.modf + q * 3072, 1 << 30, F.lds + pg8::STAGE_BYTES};
            pg8::gemm_phase<pg8::EpiOut, pg8::HalvesOrder, PG8_ALIGN, PG8_SP2>(F.lds, g, S, E);
        }
        return;
    }
#endif
#if !QUARTERS
    const int lo = args.ph_lo, hi = args.ph_hi;
#define IN(k) (lo <= (k) && (k) < hi)
#define BOTH(k) (IN(k) && IN((k) + 1))
#if P1_PRE
    f32x4 pre[4][4]; const bool use_pre = IN(0) && IN(1);
#if P1_PRE == 1
    if (use_pre) p1_preload(F, F.vcu * NWAVES + F.wave, F.G * NWAVES, pre);
#endif
#endif
    if (IN(0)) { for (int rep = 0; rep < REP_P0; ++rep) p0_prologue(F);
#if FOLD_BLOCK
      p0_fold_block(F);
#endif
#if WEIGHTS_IN_P0
      p0_weights(F, F.vcu * NWAVES + F.wave, F.G * NWAVES);
#endif
#if P1_PRE == 2
      if (use_pre && F.wave != 0) p1_preload(F, F.vcu * NWAVES + F.wave, F.G * NWAVES, pre);
      if (BOTH(0)) { if (N_LAUNCHES != PER_PHASE) xcd_barrier(bar, use_pre && F.wave != 0); } STAMP(1); }
#else
      if (BOTH(0)) GRID_BAR(); STAMP(1); }
#endif
#if P1_PRE
#define P1_PRE_ARG (use_pre && rep == 0 && (P1_PRE == 1 || F.wave != 0) && gwa * ((((MROWS + ngwa - 1) / ngwa) + 3) & ~3) + 4 <= MROWS)
#else
#define P1_PRE_ARG false
    f32x4 pre[4][4];
#endif
#if P12_OVERLAP
    bool ov_ok = (N_LAUNCHES != PER_PHASE) && (F.G == 256) && IN(1) && IN(2);
    { unsigned un = 0u; for (int k = 0; k < 8; ++k) { const unsigned m = xb_ld((unsigned*)(F.ctl + CW_GMASK + k)); ov_ok = ov_ok && m != 0u && (m & (m - 1u)) == 0u; un |= m; } ov_ok = ov_ok && __builtin_popcount(un) == 8; }
    if (ov_ok) {
        const int x = F.vcu >> 5, j = F.vcu & 31;
        unsigned* tcnt = (unsigned*)(F.ctl + CW_PC); unsigned* wcnt = (unsigned*)(F.ctl + CW_WCNT);
        if (j < 16) p1_rows_tm(F, x, j * NWAVES + F.wave, tcnt);
        else {
            const int ew = x * 128 + (j - 16) * NWAVES + F.wave;
            for (int i = ew * 64 + F.lane; i < BATCH * 3072; i += 1024 * 64) st_sc1_4(F.modf + i, mod_at(F, i / 3072, i % 3072));
            LAS float* scr = (LAS float*)(F.lds + F.wave * 16384);
            constexpr int I_TIN = 16 * 80, I_TOUT = 16 * 32, I_FOLD = 1024, NITEMS = I_TIN + I_TOUT + I_FOLD + 8;
            unsigned ndone = 2u;
            p0_fold_block(F, x * 16 + (j - 16), 128);
            (void)NITEMS;
            for (int it = I_FOLD + ew; it < NITEMS; it += 1024) { ++ndone;
                if (it < I_FOLD + 8) { p0_table_item(F, it - I_FOLD); continue; }
                const int t = it - I_FOLD - 8;
                if (t < I_TIN) { const int kb = t / 80, nbp = t % 80, nb = nbp < 48 ? nbp : nbp + 16; p0_transpose_item(F.w_in, 1024, 3072, F.Wt_in, scr, kb, nb, F.lane); }
                else { const int r = t - I_TIN; p0_transpose_item(F.w_out, 1024, 1024, F.Wt_out, scr, r / 32, r % 32, F.lane); } }
            asm volatile("s_waitcnt vmcnt(0)" ::: "memory");
            if (F.lane == 0) (void)__hip_atomic_fetch_add(wcnt, ndone, __ATOMIC_RELAXED, __HIP_MEMORY_SCOPE_AGENT);
        }
        STAMP(2);
        __syncthreads();
        pg8::Gemm g{F.XN, F.Wt_in, MROWS, NPROJ, DMODEL}; pg8::StaticOrder S; S.init(MROWS, NPROJ, F.G, (int)blockIdx.x, 1, WGM_P2);
        S.sp_mode = 1; S.sp_x = x; S.sp_cls = (j < 16) ? 1 : 0; S.sp_je = j & 15; S.tcnt = tcnt; S.wcnt = wcnt; S.wneed = 16 * 80 + 16 * 32 + 8 + 2048;
        pg8::EpiProj E{F.Qb, F.Kb, F.Vb, F.Ub, F.SZ, F.qg, F.kg, QSCALE, F.lds + pg8::STAGE_BYTES};
        pg8::gemm_phase<pg8::EpiProj, pg8::StaticOrder, PG8_ALIGN, PG8_SP2>(F.lds, g, S, E);
        if (BOTH(2)) { GRID_BAR(); }
        STAMP(3);
    } else
#endif
    {
    if (IN(1)) { const int gwa = F.vcu * NWAVES + F.wave, ngwa = F.G * NWAVES; const bool wfirst = (P1_WFIRST == 1) ? true : (P1_WFIRST == 2) ? ((F.wave & 1) || gwa >= 1024) : (P1_WFIRST == 3) ? false : (P1_WFIRST == 4) ? (gwa >= 1024) : ((F.wave & 1) != 0);
      if (!WEIGHTS_IN_P0 && wfirst) p0_weights(F, gwa, ngwa); for (int rep = 0; rep < REP_P1; ++rep) p1_xn(F, gwa, ngwa, 0, BATCH, pre, P1_PRE_ARG, P1_SHADOW_NOSTORE && rep > 0); if (!WEIGHTS_IN_P0 && !wfirst) p0_weights(F, gwa, ngwa);
#if PRETOUCH
      if (F.G == 256) {
          const int x = F.vcu >> 5, l = ((F.vcu & 31) * NWAVES + F.wave) * 64 + F.lane;
          if (l < 6144) { const int t = l >> 10, pg = l & 1023;
              unsigned char* base = (t < 4) ? (ws + WS_Q + (size_t)t * 32 * MiB + (size_t)x * 4 * MiB) : (ws + WS_SZ + (size_t)x * 8 * MiB + (size_t)(t - 4) * 4 * MiB);
              *(volatile unsigned*)(base + (size_t)pg * 4096) = 0u; } }
#endif
 if (BOTH(1)) { SEAM_BAR(); } STAMP(2); }
    if (IN(2)) {
        pg8::Gemm g{F.XN, F.Wt_in, MROWS, NPROJ, DMODEL}; pg8::StaticOrder S; S.init(MROWS, NPROJ, F.G, (int)blockIdx.x, REP_P2, WGM_P2);
        pg8::EpiProj E{F.Qb, F.Kb, F.Vb, F.Ub, F.SZ, F.qg, F.kg, QSCALE, F.lds + pg8::STAGE_BYTES};
#if P2_STAGGER_TICKS > 0
        if (blockIdx.x & 8) { const unsigned long long t0_ = __builtin_amdgcn_s_memrealtime(); while (__builtin_amdgcn_s_memrealtime() - t0_ < P2_STAGGER_TICKS) __builtin_amdgcn_s_sleep(16); }
#endif
        pg8::gemm_phase<pg8::EpiProj, pg8::StaticOrder, PG8_ALIGN, PG8_SP2>(F.lds, g, S, E);
#if PROBE_P2B
        GRID_BAR();
        pg8::gemm_phase<pg8::EpiProj, pg8::StaticOrder, PG8_ALIGN, PG8_SP2>(F.lds, g, S, E);
#endif
        if (BOTH(2)) { SEAM_BAR(); }
        STAMP(3);
    }
    }
#if SPLIT34
    if (IN(3) && IN(4)) {
        const int upc = (att::NUNITS + F.G - 1) / F.G;
        bool local_ok = (N_LAUNCHES != PER_PHASE) && (F.G == 256);
        { unsigned un = 0u; for (int k = 0; k < 8; ++k) { const unsigned m = xb_ld((unsigned*)(F.ctl + CW_GMASK + k)); local_ok = local_ok && m != 0u && (m & (m - 1u)) == 0u; un |= m; }
          local_ok = local_ok && __builtin_popcount(un) == 8; }
        const int x = F.vcu >> 5, j = F.vcu & 31;
        const bool split = local_ok && ((x & 1) == SPLIT34 - 1);
        const int nst = split ? 2 : 1;
        int i0 = F.vcu * upc, i1 = (i0 + upc < att::NUNITS) ? i0 + upc : att::NUNITS;
        if (F.G == 256) { i0 = (x >> 1) * 256 + (j >> 2) * 32 + 16 * (x & 1) + 4 * (j & 3); i1 = i0 + 4; }
#define SPLIT_STAGE(STG) do { \
                const att::Tensors AT{PLOAD(const att::bf16*, 0), PLOAD(const att::bf16*, 1), PLOAD(const att::bf16*, 2), PLOAD(const att::bf16*, 3), PLOAD(const att::bf16*, 4), PLOAD(att::bf16*, 5), PLOAD(const float*, 6)}; \
                int idx = split ? i0 + 2 * (STG) : i0; const int ie = split ? idx + 2 : i1; \
                while (idx < ie) { \
                    if ((idx & 31) < 2) { att::attn_unit(idx >> 8, (idx >> 5) & 7, idx & 31, AT, (char*)lds); ++idx; continue; } \
                    int e = idx + 1; while (e < ie && (e & 31) != 0) ++e; \
                    att::attn_run_p<0>(idx >> 8, (idx >> 5) & 7, idx & 31, e - idx, AT, (char*)lds); \
                    idx = e; \
                } \
                if (F.G == 256) { const int lw = j * NWAVES + F.wave, per = att::NPOOL_ITEMS / 8; \
                    if (split) { const int Rp = lw >> 5, R = (Rp >> 1) * 4 + 2 * (STG) + (Rp & 1); att::pool_dispatch(per * x + R * 32 + (lw & 31), AT, F.lane); }     \
                    else att::pool_dispatch64(lw, (long)x * 4096, AT, F.lane); } \
                else { const int gw = F.vcu * NWAVES + F.wave, NGW = F.G * NWAVES; \
                    for (int it = gw; it < att::NPOOL_ITEMS; it += NGW) att::pool_dispatch(it, AT, F.lane); } \
                if (local_ok) xcd_local_barrier(bar, (unsigned*)(F.ctl + CW_LB), (unsigned)(STG)); else GRID_BAR(); \
                pg8::Gemm g{PLOAD(const bf16*, 5), PLOAD(const bf16*, 7), MROWS, DMODEL, DMODEL}; \
                pg8::EpiOut E{PLOAD(const float*, 8), PLOAD(float*, 9), PLOAD(const float*, 10), SEQ, F.lds + pg8::STAGE_BYTES}; \
                pg8::StageOrder SO; SO.S.init(MROWS, DMODEL, F.G, (int)blockIdx.x, 1, WGM_P4); SO.split = split ? 1 : 0; SO.st = (STG); SO.x = x; SO.j = j; \
                pg8::gemm_phase<pg8::EpiOut, pg8::StageOrder, P4_ALIGN, PG8_SP2>(F.lds, g, SO, E); \
        } while (0)
        SPLIT_STAGE(0);
        if (split) SPLIT_STAGE(1);
#undef SPLIT_STAGE
    }
#else
    if (IN(3)) {
        const att::Tensors AT{(const att::bf16*)F.Qb, (const att::bf16*)F.Kb, (const att::bf16*)F.Vb, (const att::bf16*)F.Ub, (const att::bf16*)F.SZ, (att::bf16*)F.Y, F.tbg};
        const int upc = (att::NUNITS + F.G - 1) / F.G;
#if SHADOW_VAR >= 0
        const att::Tensors ATS{AT.Q, AT.K, AT.V, AT.U, AT.SZ, (att::bf16*)(args.ws + WS_END), AT.tbg};
#endif
#if POOL_FIRST
#define POOL_ITEMS() do { if (SLAB_ATT && F.G == 256) { const int x = F.vcu >> 5, lw = (F.vcu & 31) * NWAVES + F.wave, per = att::NPOOL_ITEMS / 8; \
          for (int it = lw; it < per; it += 32 * NWAVES) att::pool_dispatch(per * x + it, AT, F.lane); } else { const int gw = F.vcu * NWAVES + F.wave, NGW = F.G * NWAVES; \
          for (int it = gw; it < att::NPOOL_ITEMS * REP_P3B; it += NGW) att::pool_dispatch(it % att::NPOOL_ITEMS, AT, F.lane); } } while (0)
        const bool pool_first = (POOL_FIRST == 2) ? true : (POOL_FIRST == 3) ? ((blockIdx.x & 1) != 0) : ((blockIdx.x >> 3) & 1) != 0;
        if (pool_first) POOL_ITEMS();
#endif
#if !(DBG_NAIVE & 32)
        for (int rep_ = 0; rep_ < REP_P3A; ++rep_) {
#if SLAB_ATT
            int i0 = F.vcu * upc, i1 = (i0 + upc < att::NUNITS) ? i0 + upc : att::NUNITS;
            if (F.G == 256) { const int x = F.vcu >> 5, j = F.vcu & 31;
                i0 = (x >> 1) * 256 + (j >> 2) * 32 + 16 * (x & 1) + 4 * (j & 3); i1 = i0 + 4; }
#else
            const int i0 = F.vcu * upc, i1 = (i0 + upc < att::NUNITS) ? i0 + upc : att::NUNITS;
#endif
            int idx = i0;
            while (idx < i1) {
                if ((idx & 31) < 2) { att::attn_unit(idx >> 8, (idx >> 5) & 7, idx & 31, AT, (char*)lds); ++idx; continue; }
                int e = idx + 1; while (e < i1 && (e & 31) != 0) ++e;
                if (rep_ == 0) att::attn_run_p<0>(idx >> 8, (idx >> 5) & 7, idx & 31, e - idx, AT, (char*)lds);
#if SHADOW_VAR >= 0
                else att::attn_run_p<SHADOW_VAR>(idx >> 8, (idx >> 5) & 7, idx & 31, e - idx, ATS, (char*)lds);
#endif
                idx = e;
            }
        }
#endif
        STAMP(6);
#if POOL_SPLIT
        bool ps_ok = (N_LAUNCHES != PER_PHASE) && (F.G == 256) && BOTH(3);
        { unsigned un = 0u; for (int k = 0; k < 8; ++k) { const unsigned m = xb_ld((unsigned*)(F.ctl + CW_GMASK + k)); ps_ok = ps_ok && m != 0u && (m & (m - 1u)) == 0u; un |= m; } ps_ok = ps_ok && __builtin_popcount(un) == 8; }
        if (ps_ok) {
            xcd_local_barrier(bar, (unsigned*)(F.ctl + CW_LB));
            const int x = F.vcu >> 5, j = F.vcu & 31;
            if (j & 1) {
                const int e = (j >> 1) * NWAVES + F.wave;
#pragma unroll
                for (int r = 0; r < 2; ++r) {
                    const int R = 2 * (e >> 4) + r, i16 = (r == 0) ? (e & 15) : ((e & 12) | ((e + 2) & 3)), lw = R * 16 + i16;
                    int lane_ = F.lane; asm volatile("" : "+v"(lane_));
                    att::pool_dispatch64(lw, (long)x * 4096, AT, lane_);
                    asm volatile("s_waitcnt vmcnt(0)" ::: "memory");
                    if (F.lane == 0) (void)__hip_atomic_fetch_add((unsigned*)(F.ctl + CW_PC + 64 * (16 * x + R)), 1u, __ATOMIC_RELAXED, __HIP_MEMORY_SCOPE_AGENT);
                }
            }
        } else
#endif
        {
#if POOL_FIRST
        if (!pool_first) POOL_ITEMS();
#elif !(DBG_NAIVE & 64)
#if SLAB_ATT
#if POOL64
        if (F.G == 256) { const int x = F.vcu >> 5, lw = (F.vcu & 31) * NWAVES + F.wave; att::pool_dispatch64(lw, (long)x * 4096, AT, F.lane); }
#else
        if (F.G == 256) { const int x = F.vcu >> 5, lw = (F.vcu & 31) * NWAVES + F.wave, per = att::NPOOL_ITEMS / 8;
          for (int it = lw; it < per; it += 32 * NWAVES) att::pool_dispatch(per * x + it, AT, F.lane); }
#endif
        else
#endif
        { const int gw = F.vcu * NWAVES + F.wave, NGW = F.G * NWAVES;
          for (int it = gw; it < att::NPOOL_ITEMS * REP_P3B; it += NGW) att::pool_dispatch(it % att::NPOOL_ITEMS, AT, F.lane); }
#endif
#if LOCAL_P34 && SLAB_ATT
        if (BOTH(3)) {
            bool local_ok = (N_LAUNCHES != PER_PHASE) && (F.G == 256);
            for (int k = 0; k < 8; ++k) { const unsigned m = xb_ld((unsigned*)(F.ctl + CW_GMASK + k)); local_ok = local_ok && m != 0u && (m & (m - 1u)) == 0u; }
            if (local_ok) xcd_local_barrier(bar, (unsigned*)(F.ctl + CW_LB)); else GRID_BAR();
        }
#else
        if (BOTH(3)) GRID_BAR();
#endif
        }
        STAMP(4);
    }
    if (IN(4)) {
        pg8::Gemm g{F.Y, F.Wt_out, MROWS, DMODEL, DMODEL}; pg8::StaticOrder S; S.init(MROWS, DMODEL, F.G, (int)blockIdx.x, REP_P4, WGM_P4);
#if POOL_SPLIT
        { bool ok2 = (N_LAUNCHES != PER_PHASE) && (F.G == 256) && IN(3); unsigned un = 0u;
          for (int k = 0; k < 8; ++k) { const unsigned m = xb_ld((unsigned*)(F.ctl + CW_GMASK + k)); ok2 = ok2 && m != 0u && (m & (m - 1u)) == 0u; un |= m; }
          if (ok2 && __builtin_popcount(un) == 8) S.cnt = (unsigned*)(F.ctl + CW_PC); }
#endif
        pg8::EpiOut E{F.x, F.out, F.modf, SEQ, F.lds + pg8::STAGE_BYTES};
#if SHADOW_EPI4 >= 2
        E.out_sh = (float*)(ws + 96 * MiB);
#endif
#if XB_RESID
        E.xb = (const pg8::bf16_t*)F.XB;
#endif
#if P4_STAGGER_TICKS > 0
        if (blockIdx.x & 8) { const unsigned long long t0_ = __builtin_amdgcn_s_memrealtime(); while (__builtin_amdgcn_s_memrealtime() - t0_ < P4_STAGGER_TICKS) __builtin_amdgcn_s_sleep(16); }
#endif
#if X_TOUCH
        unsigned xt_ = 0u;
        if (F.G == 256 && F.lane < 16) { const float* xp_ = F.x + ((size_t)(F.vcu >> 5) * 4096 + (size_t)(((F.vcu & 31) * NWAVES + F.wave) * 16 + F.lane)) * 1024;
            asm volatile("global_load_dword %0, %1, off" : "+v"(xt_) : "v"(xp_) : "memory"); }
#endif
        pg8::gemm_phase<pg8::EpiOut, pg8::StaticOrder, P4_ALIGN, PG8_SP2>(F.lds, g, S, E);
#if X_TOUCH
        asm volatile("" :: "v"(xt_));
#endif
        STAMP(7);
    }
#endif
#if PROBE_STAMP >= 0
    GRID_BAR(); STAMP(5);
    if (blockIdx.x == PROBE_BLK && F.tid == 0) {
        const unsigned long long ta = ((unsigned long long)F.MISC[17 + 2 * PROBE_STAMP] << 32) | F.MISC[16 + 2 * PROBE_STAMP], tb = ((unsigned long long)F.MISC[17 + 2 * PROBE_STAMP_B] << 32) | F.MISC[16 + 2 * PROBE_STAMP_B];
        const unsigned long long t5 = __builtin_amdgcn_s_memrealtime(), want = (tb - ta) * PROBE_AMP;
        while (__builtin_amdgcn_s_memrealtime() - t5 < want) __builtin_amdgcn_s_sleep(8);
    }
#endif
#undef IN
#undef BOTH
#endif
#undef GRID_BAR
}


#ifndef DBG_NAIVE
#define DBG_NAIVE 0
#endif
#if DBG_NAIVE
__device__ __forceinline__ float dbg_bf(bf16 v) { return __builtin_bit_cast(float, (unsigned)v << 16); }
__device__ __forceinline__ bf16 dbg_tobf(float f) { return (bf16)f2bf(f); }
__global__ void __launch_bounds__(256) dbg_gemm_bf16(const bf16* __restrict__ A, int lda, const bf16* __restrict__ Bt, int ldb, float* __restrict__ C, int ldc, int K) {
    __shared__ float As[16][64 + 4];
    __shared__ float Bs[16][64 + 4];
    const int tid = threadIdx.x, tx = tid & 15, ty = tid >> 4;
    const int m0 = blockIdx.y * 64, n0 = blockIdx.x * 64;
    float acc[4][4] = {};
    for (int k0 = 0; k0 < K; k0 += 16) {
        { const int r = tid >> 2, kk = (tid & 3) * 4;
#pragma unroll
          for (int j = 0; j < 4; ++j) { As[kk + j][r] = dbg_bf(A[(size_t)(m0 + r) * lda + k0 + kk + j]); Bs[kk + j][r] = dbg_bf(Bt[(size_t)(n0 + r) * ldb + k0 + kk + j]); } }
        __syncthreads();
#pragma unroll
        for (int kk = 0; kk < 16; ++kk) {
            const float4 a = *(const float4*)&As[kk][ty * 4]; const float4 b = *(const float4*)&Bs[kk][tx * 4];
            const float av[4] = {a.x, a.y, a.z, a.w}, bv[4] = {b.x, b.y, b.z, b.w};
#pragma unroll
            for (int i = 0; i < 4; ++i)
#pragma unroll
                for (int j = 0; j < 4; ++j) acc[i][j] += av[i] * bv[j];
        }
        __syncthreads();
    }
    for (int i = 0; i < 4; ++i) *(float4*)(C + (size_t)(m0 + ty * 4 + i) * ldc + n0 + tx * 4) = make_float4(acc[i][0], acc[i][1], acc[i][2], acc[i][3]);
}
__global__ void dbg_epi_slab(const float* __restrict__ Cs, int s, bf16* Qb, bf16* Kb, bf16* Vb, bf16* Ub, bf16* SZ, const float* qg, const float* kg) {
    const int idx = blockIdx.x * 256 + threadIdx.x; const int row = idx >> 3, hh = idx & 7;
    const float* p = Cs + (size_t)row * 512 + hh * 64;
    if (s < 2) { float ss = 0.f; for (int d = 0; d < 64; ++d) ss += p[d] * p[d];
        const float r = 1.0f / sqrtf(ss / 64.f + 1e-6f); const float* g = s == 0 ? qg : kg; const float sc = s == 0 ? QSCALE : 1.0f; bf16* o = (s == 0 ? Qb : Kb) + (size_t)row * 512 + hh * 64;
        for (int d = 0; d < 64; ++d) o[d] = dbg_tobf(p[d] * r * g[d] * sc); }
    else if (s < 4) { bf16* o = (s == 2 ? Vb : Ub) + (size_t)row * 512 + hh * 64; for (int d = 0; d < 64; ++d) o[d] = dbg_tobf(p[d]); }
    else { bf16* o = SZ + (size_t)row * 1024 + (s - 4) * 512 + hh * 64; for (int d = 0; d < 64; ++d) { const float z = p[d]; o[d] = dbg_tobf(z / (1.0f + __expf(-z))); } }
}
__global__ void __launch_bounds__(64) dbg_attn(const bf16* __restrict__ Qb, const bf16* __restrict__ Kb, const bf16* __restrict__ Vb, const bf16* __restrict__ SZ, bf16* __restrict__ Y, const float* __restrict__ rel_bias) {
    const int idx = blockIdx.x * 64 + threadIdx.x;
    const int i = idx % SEQ, bh = idx / SEQ, h = bh % NHEAD, b = bh / NHEAD;
    const size_t row = (size_t)b * SEQ + i;
    float q[64], o[64];
#pragma unroll
    for (int d = 0; d < 64; ++d) { q[d] = dbg_bf(Qb[row * 512 + h * 64 + d]); o[d] = 0.f; }
    const int n = i / 64; int j0 = (n - 8) * 64; if (j0 < 0) j0 = 0; const int j1 = n * 64 + 63;
    float mx = -1e30f, l = 0.f;
    for (int j = j0; j <= j1; ++j) {
        const bf16* kp = Kb + ((size_t)b * SEQ + j) * 512 + h * 64; const bf16* vp = Vb + ((size_t)b * SEQ + j) * 512 + h * 64;
        float sc = 0.f;
#pragma unroll
        for (int d = 0; d < 64; ++d) sc += q[d] * dbg_bf(kp[d]);
        int rel = j - i; rel = rel < -256 ? -256 : (rel > 256 ? 256 : rel);
        sc += rel_bias[h * 513 + rel + 256] * LOG2E;
        const float mn = fmaxf(mx, sc), f = exp2f(mx - mn), p = exp2f(sc - mn);
        l = l * f + p; mx = mn;
#pragma unroll
        for (int d = 0; d < 64; ++d) o[d] = o[d] * f + p * dbg_bf(vp[d]);
    }
    const float rl = 1.0f / l;
#pragma unroll
    for (int d = 0; d < 64; ++d) Y[row * 1024 + h * 64 + d] = dbg_tobf(o[d] * rl * dbg_bf(SZ[row * 1024 + h * 64 + d]));
}
__global__ void dbg_pool(const bf16* __restrict__ Ub, const bf16* __restrict__ SZ, bf16* __restrict__ Y) {
    const int idx = blockIdx.x * 256 + threadIdx.x; const int row = idx >> 9, ch = idx & 511, g = ch >> 7, w = 2 << g;
    const int t = row % SEQ; const int cnt = (t + 1 < w) ? t + 1 : w;
    float s = 0.f; for (int a = 0; a < cnt; ++a) s += dbg_bf(Ub[(size_t)(row - a) * 512 + ch]);
    Y[(size_t)row * 1024 + 512 + ch] = dbg_tobf((s / (float)cnt - dbg_bf(Ub[(size_t)row * 512 + ch])) * dbg_bf(SZ[(size_t)row * 1024 + 512 + ch]));
}
__global__ void dbg_out(float* __restrict__ out, const float* __restrict__ x, const float* __restrict__ modf) {
    const size_t idx = (size_t)blockIdx.x * 256 + threadIdx.x; const size_t row = idx >> 10; const int cidx = (int)(idx & 1023); const int b = (int)(row / SEQ);
    out[idx] = x[idx] + modf[b * 3072 + 2048 + cidx] * out[idx];
}
#endif

extern "C" void kernel_launch(void* const* d_in, const int* in_sizes, int n_in, void* d_out, int out_size, void* d_ws, size_t ws_size, hipStream_t stream) {
    static int grid = 0;
    if (grid == 0) {
        if (n_in != 12 || in_sizes[0] != MROWS * DMODEL || out_size != MROWS * DMODEL || ws_size < WS_END) { fprintf(stderr, "kernel_launch: unexpected shapes (n_in %d, in0 %d, out %d, ws %zu); nothing launched\n", n_in, n_in > 0 ? in_sizes[0] : -1, out_size, ws_size); grid = -1; return; }
        int dev = 0, cus = 0, per_cu = 0;
        if (hipGetDevice(&dev) != hipSuccess || hipDeviceGetAttribute(&cus, hipDeviceAttributeMultiprocessorCount, dev) != hipSuccess) { grid = -1; return; }
        if (hipFuncSetAttribute((const void*)mk_fwd, hipFuncAttributeMaxDynamicSharedMemorySize, LDS_BYTES) != hipSuccess) { fprintf(stderr, "kernel_launch: hipFuncSetAttribute failed\n"); grid = -1; return; }
        if (hipOccupancyMaxActiveBlocksPerMultiprocessor(&per_cu, (const void*)mk_fwd, NWAVES * 64, LDS_BYTES) != hipSuccess || per_cu < 1) { fprintf(stderr, "kernel_launch: occupancy query reports %d workgroups per CU\n", per_cu); per_cu = 0; }
        (void)hipGetLastError();
#if QUARTERS
        if (cus % 32 != 0) { fprintf(stderr, "kernel_launch: the staggered-groups build needs a CU count that is a multiple of 32 (got %d); nothing launched\n", cus); grid = -1; return; }
#endif
        grid = cus * (per_cu >= 1 ? 1 : 0);
        if (grid == 0) { grid = -1; return; }
    }
    if (grid < 0) return;
    for (int pass_ = 0; pass_ < REP_ALL; ++pass_) {
#if WS_AT_END
    unsigned char* const wsb = (unsigned char*)d_ws + ((ws_size - WS_END) & ~(size_t)(MiB - 1));
#else
    unsigned char* const wsb = (unsigned char*)d_ws;
#endif
    for (int ms_ = 0; ms_ < REP_MEMSET; ++ms_) (void)hipMemsetAsync((char*)wsb + WS_CTL, 0, CTL_ZERO_BYTES, stream);
    Args a{};
    for (int i = 0; i < 12; ++i) a.in[i] = (const float*)d_in[i];
    a.out = (float*)d_out; a.ws = wsb;
    a.xn = wsb + WS_XN;
    a.tn[0] = wsb + WS_Q; a.tn[1] = wsb + WS_K; a.tn[2] = wsb + WS_V; a.tn[3] = wsb + WS_U; a.tn[4] = wsb + WS_SZ; a.tn[5] = wsb + WS_Y;
#if LAYOUT >= 1
    {
        unsigned char* const E = (unsigned char*)d_ws + (ws_size & ~(size_t)(MiB - 1));
        if (ws_size >= 80 * MiB + 256 * MiB) {
            a.xn = E - 64 * MiB; a.tn[5] = wsb + WS_XN;
#if LAYOUT == 1 || LAYOUT == 3 || LAYOUT == 4
            a.tn[0] = E - 192 * MiB; a.tn[1] = E - 160 * MiB; a.tn[2] = E - 128 * MiB; a.tn[3] = E - 96 * MiB; a.tn[4] = E - 256 * MiB;
#elif LAYOUT == 2
            a.tn[4] = E - 128 * MiB; a.tn[0] = E - 256 * MiB; a.tn[1] = E - 224 * MiB; a.tn[2] = E - 192 * MiB; a.tn[3] = E - 160 * MiB;
#endif
#if LAYOUT == 8
            {
                a.xn = E - (size_t)L8_XN; unsigned char* qb = E - (size_t)L8_Q; const size_t st = 32 * MiB + (size_t)L8_PAD;
                a.tn[0] = qb; a.tn[1] = qb + st; a.tn[2] = qb + 2 * st; a.tn[3] = qb + 3 * st; a.tn[4] = (L8_SZ == 0) ? (wsb + WS_XN) : (E - (size_t)L8_SZ - (size_t)L8_SZB); a.tn[5] = a.tn[4]; }
#endif
#if LAYOUT == 6
            a.xn = E - 256 * MiB; a.tn[0] = E - 192 * MiB; a.tn[1] = E - 160 * MiB; a.tn[2] = E - 128 * MiB; a.tn[3] = E - 96 * MiB; a.tn[4] = E - 64 * MiB; a.tn[5] = a.tn[4];
#elif LAYOUT == 7
            a.xn = E - 64 * MiB; a.tn[4] = E - 128 * MiB; a.tn[0] = E - 256 * MiB; a.tn[1] = E - 224 * MiB; a.tn[2] = E - 192 * MiB; a.tn[3] = E - 160 * MiB; a.tn[5] = a.tn[4];
#endif
#if LAYOUT == 3
            a.tn[5] = a.xn;
#elif LAYOUT == 4
            a.tn[5] = a.tn[4];
#endif
        }
    }
#endif
#if XN_PLACE == 1
    if (ws_size >= WS_END + 64 * MiB) a.xn = (unsigned char*)d_ws + ((ws_size - 64 * MiB) & ~(size_t)(MiB - 1));
#elif XN_PLACE == 2
    a.xn = (unsigned char*)d_out + 64 * MiB;
#elif XN_PLACE == 3
    a.xn = (unsigned char*)d_out;
#elif XN_PLACE == 5
    if (ws_size >= WS_END + 128 * MiB) a.xn = (unsigned char*)d_ws + ((ws_size - 128 * MiB) & ~(size_t)(MiB - 1));
#elif XN_PLACE == 6
    if (ws_size >= WS_END + 64 * MiB) a.xn = (unsigned char*)d_ws + ((ws_size - 64 * MiB) & ~(size_t)(MiB - 1)) - XN_SHIFT;
#elif XN_PLACE == 4
    if (ws_size >= WS_END + 64 * MiB) a.xn = wsb + WS_END;
#endif
    for (int li = 0; li < N_LAUNCHES; ++li) {
        a.ph_lo = (N_LAUNCHES == PER_PHASE) ? li : 0; a.ph_hi = (N_LAUNCHES == PER_PHASE) ? li + 1 : PER_PHASE; a.li = li;
#if DBG_NAIVE
        if ((DBG_NAIVE >> li) & 1) {
            unsigned char* ws = (unsigned char*)d_ws; bf16 *XN = (bf16*)(ws + WS_XN), *Wt_in = (bf16*)(ws + WS_WIN), *Wt_out = (bf16*)(ws + WS_WOUT), *Qb = (bf16*)(ws + WS_Q), *Kb = (bf16*)(ws + WS_K), *Vb = (bf16*)(ws + WS_V), *Ub = (bf16*)(ws + WS_U), *SZ = (bf16*)(ws + WS_SZ), *Y = (bf16*)(ws + WS_Y);
            float* tmp = (float*)(ws + WS_END); float* modf = (float*)(ws + WS_MOD);
            if (li == 2) { for (int s = 0; s < 6; ++s) { dbg_gemm_bf16<<<dim3(512 / 64, MROWS / 64), 256, 0, stream>>>(XN, 1024, Wt_in + (size_t)s * 512 * 1024, 1024, tmp, 512, 1024);
                    dbg_epi_slab<<<MROWS * 8 / 256, 256, 0, stream>>>(tmp, s, Qb, Kb, Vb, Ub, SZ, a.in[6], a.in[7]); } continue; }
            if (li == 3) { dbg_attn<<<BATCH * NHEAD * SEQ / 64, 64, 0, stream>>>(Qb, Kb, Vb, SZ, Y, a.in[8]); dbg_pool<<<MROWS * 512 / 256, 256, 0, stream>>>(Ub, SZ, Y); continue; }
            if (li == 4) { dbg_gemm_bf16<<<dim3(1024 / 64, MROWS / 64), 256, 0, stream>>>(Y, 1024, Wt_out, 1024, (float*)d_out, 1024, 1024); dbg_out<<<MROWS * 1024 / 256, 256, 0, stream>>>((float*)d_out, a.in[0], modf); continue; }
        }
#endif
#if USE_COOP
        { void* kargs[] = {(void*)&a}; const hipError_t ce = hipLaunchCooperativeKernel((const void*)mk_fwd, dim3(grid), dim3(NWAVES * 64), kargs, LDS_BYTES, stream);
          if (ce != hipSuccess) fprintf(stderr, "kernel_launch: cooperative launch failed: %s (grid %d)\n", hipGetErrorString(ce), grid); }
#else
        hipLaunchKernelGGL(mk_fwd, dim3(grid), dim3(NWAVES * 64), LDS_BYTES, stream, a);
#endif
#if DBG_NAIVE & 96
        if (li == 3) { unsigned char* ws = (unsigned char*)d_ws; bf16 *Qb = (bf16*)(ws + WS_Q), *Kb = (bf16*)(ws + WS_K), *Vb = (bf16*)(ws + WS_V), *Ub = (bf16*)(ws + WS_U), *SZ = (bf16*)(ws + WS_SZ), *Y = (bf16*)(ws + WS_Y);
            if (DBG_NAIVE & 32) dbg_attn<<<BATCH * NHEAD * SEQ / 64, 64, 0, stream>>>(Qb, Kb, Vb, SZ, Y, a.in[8]);
            if (DBG_NAIVE & 64) dbg_pool<<<MROWS * 512 / 256, 256, 0, stream>>>(Ub, SZ, Y); }
#endif
    }
    }
}
```
